# Optimizing an MI355X kernel written in HIP

```python
import jax, jax.numpy as jnp
from jax import lax
import numpy as np

D_MODEL = 1024
BATCH = 8
SEQ = 2048
DEPTH = 2
DEC_BATCH = 128
DEC_SEQ = 1
PAST_LEN = 16384
PAGE_SIZE = 128

HEAD_SIZE = 64
N_HEADS = D_MODEL // HEAD_SIZE
D_RWKV = N_HEADS * HEAD_SIZE
D_DECAY_LORA = 64
D_AAA_LORA = 64
D_GATE_LORA = 128
POOL_WINDOWS = (2, 4, 8, 16)
N_POOL_GROUPS = len(POOL_WINDOWS)
POOL_GROUP = D_MODEL // 8
D_POOL = N_POOL_GROUPS * POOL_GROUP
POOL_BUF = max(POOL_WINDOWS) - 1
D_FF = (D_MODEL * 11) // 4
CONV_W = 3
D_SHIFT = 3 * D_RWKV + D_DECAY_LORA + D_AAA_LORA + D_GATE_LORA
IN_COLS = D_SHIFT + D_POOL + 2 * D_MODEL
ALPHA = float((2 * DEPTH) ** 0.25)
BETA = float((8 * DEPTH) ** -0.25)
LN_EPS = 1e-5
GN_EPS = 64e-5

kernel_name = 'hybrid_pool_rwkv7_convffn_deepnorm_step'


def layer_norm(x, w=None, b=None):
    xf = x.astype(jnp.float32)
    mu = jnp.mean(xf, axis=-1, keepdims=True)
    var = jnp.mean(jnp.square(xf - mu), axis=-1, keepdims=True)
    y = (xf - mu) * lax.rsqrt(var + LN_EPS)
    if w is not None:
        y = y * w + b
    return y


def rwkv7_recurrence(state0, r, w, k, v, kk, a):
    def step(S, inp):
        r_t, w_t, k_t, v_t, kk_t, a_t = inp
        sa = jnp.einsum('bhvk,bhk->bhv', S, kk_t)
        S = (S * w_t[:, :, None, :]
             - sa[..., None] * (kk_t * a_t)[:, :, None, :]
             + v_t[..., None] * k_t[:, :, None, :])
        y = jnp.einsum('bhvk,bhk->bhv', S, r_t)
        return S, y
    xs = (jnp.moveaxis(r, 1, 0), jnp.moveaxis(w, 1, 0), jnp.moveaxis(k, 1, 0),
          jnp.moveaxis(v, 1, 0), jnp.moveaxis(kk, 1, 0), jnp.moveaxis(a, 1, 0))
    S, ys = lax.scan(step, state0, xs)
    return jnp.moveaxis(ys, 0, 1), S


def pool_mix(p_in, buf, pos0, pool_w, pool_scale):
    B, T, _ = p_in.shape
    ext = jnp.concatenate([buf.astype(jnp.float32), p_in.astype(jnp.float32)], axis=1)
    cs = jnp.pad(jnp.cumsum(ext, axis=1), ((0, 0), (1, 0), (0, 0)))
    end = cs[:, POOL_BUF + 1:]
    pos = pos0 + jnp.arange(T)
    groups = []
    for g, win in enumerate(POOL_WINDOWS):
        sl = slice(g * POOL_GROUP, (g + 1) * POOL_GROUP)
        start = cs[:, POOL_BUF + 1 - win: POOL_BUF + 1 - win + T, sl]
        cnt = jnp.minimum(win, pos + 1).astype(jnp.float32)[None, :, None]
        groups.append((end[..., sl] - start) / cnt)
    pooled = jnp.stack(groups, axis=2)
    diff = pooled - p_in.astype(jnp.float32).reshape(B, T, N_POOL_GROUPS, POOL_GROUP)
    mixed = jnp.einsum('btgc,gcd->btgd', diff, pool_w).reshape(B, T, D_POOL) * pool_scale
    return mixed, ext[:, -POOL_BUF:]


def token_mixer(h, shift_prev, wkv_prev, pool_prev, pos0, l, p):
    B, T, _ = h.shape
    w_in = p['w_in'][l]
    proj = jnp.einsum('btd,de->bte', h, w_in)
    prev_proj = jnp.einsum('bd,de->be', shift_prev.astype(jnp.float32), w_in[:, :D_SHIFT])
    cur = proj[..., :D_SHIFT]
    prev_rows = jnp.concatenate([prev_proj[:, None], cur[:, :-1]], axis=1)
    xs = cur + (prev_rows - cur) * p['mu_shift'][l]
    splits = [D_RWKV, 2 * D_RWKV, 3 * D_RWKV, 3 * D_RWKV + D_DECAY_LORA,
              3 * D_RWKV + D_DECAY_LORA + D_AAA_LORA]
    r, k, v, wl, al, gl = jnp.split(xs, splits, axis=-1)
    w_log = -jax.nn.softplus(-(p['decay_w0'][l] + jnp.tanh(wl) @ p['decay_up'][l])) - 0.5
    decay = jnp.exp(-jnp.exp(w_log))
    a = jax.nn.sigmoid(p['aaa_a0'][l] + al @ p['aaa_up'][l])
    g = jax.nn.sigmoid(gl) @ p['gate_up'][l]
    kk = k * p['k_k'][l]
    k = k * (1.0 + (a - 1.0) * p['k_a'][l])
    hs = lambda t: t.reshape(B, T, N_HEADS, HEAD_SIZE)
    kk_h = hs(kk)
    kk_h = kk_h / jnp.maximum(jnp.sqrt(jnp.sum(jnp.square(kk_h), axis=-1, keepdims=True)), 1e-12)
    r_h, k_h, v_h = hs(r), hs(k), hs(v)
    y, S_new = rwkv7_recurrence(wkv_prev.astype(jnp.float32), r_h, hs(decay), k_h, v_h, kk_h, hs(a))
    mu = jnp.mean(y, axis=-1, keepdims=True)
    var = jnp.mean(jnp.square(y - mu), axis=-1, keepdims=True)
    y = ((y - mu) * lax.rsqrt(var + GN_EPS)).reshape(B, T, D_RWKV) * p['gn_w'][l] + p['gn_b'][l]
    bonus = jnp.sum(r_h * k_h * p['r_k'][l], axis=-1, keepdims=True) * v_h
    y = y + bonus.reshape(B, T, D_RWKV)
    y_rwkv = (y * g) @ p['w_branch_rwkv'][l]
    p_in = proj[..., D_SHIFT:D_SHIFT + D_POOL]
    pooled, pool_new = pool_mix(p_in, pool_prev, pos0, p['pool_w'][l], p['pool_scale'][l])
    y_pool = pooled @ p['w_branch_pool'][l]
    gate_pool, gate_rwkv = jnp.split(proj[..., D_SHIFT + D_POOL:], 2, axis=-1)
    merged = jax.nn.sigmoid(gate_pool) * y_pool + jax.nn.sigmoid(gate_rwkv) * y_rwkv
    out = merged @ p['w_out'][l]
    return out, h[:, -1], S_new, pool_new


def conv_ffn(h, conv_prev, l, p):
    T = h.shape[1]
    u = jnp.einsum('btd,df->btf', h, p['ffn_up'][l])
    ext = jnp.concatenate([conv_prev.astype(jnp.float32), u], axis=1)
    cw = p['conv_w'][l]
    conv = p['conv_b'][l] + ext[:, 0:T] * cw[0] + ext[:, 1:T + 1] * cw[1] + ext[:, 2:T + 2] * cw[2]
    val, gate = jnp.split(conv, 2, axis=-1)
    out = (val * jax.nn.silu(gate)) @ p['ffn_down'][l]
    return out, ext[:, -(CONV_W - 1):]


def run_trunk(x, c, pos0, shift_st, wkv_st, pool_st, conv_st, p):
    x = x.astype(jnp.float32)
    c = c.astype(jnp.float32)
    n_shift, n_wkv, n_pool, n_conv = [], [], [], []
    for l in range(DEPTH):
        mod = jnp.einsum('bd,de->be', c, p['ada_w'][l]) + p['ada_b'][l]
        sh1, sc1, g1, sh2, sc2, g2 = jnp.split(mod[:, None, :], 6, axis=-1)
        h = layer_norm(x) * (1.0 + sc1) + sh1
        mix, s_shift, s_wkv, s_pool = token_mixer(h, shift_st[l], wkv_st[l], pool_st[l], pos0, l, p)
        x = layer_norm(ALPHA * x + (1.0 + g1) * mix, p['ln1_w'][l], p['ln1_b'][l])
        h2 = layer_norm(x) * (1.0 + sc2) + sh2
        ff, s_conv = conv_ffn(h2, conv_st[l], l, p)
        x = layer_norm(ALPHA * x + (1.0 + g2) * ff, p['ln2_w'][l], p['ln2_b'][l])
        n_shift.append(s_shift)
        n_wkv.append(s_wkv)
        n_pool.append(s_pool)
        n_conv.append(s_conv)
    return x, jnp.stack(n_shift), jnp.stack(n_wkv), jnp.stack(n_pool), jnp.stack(n_conv)


def setup_inputs(seed: int = 0) -> dict:
    key = jax.random.key(seed)
    ks = iter(jax.random.split(key, 48))
    nrm = lambda shape, s: jax.random.normal(next(ks), shape, jnp.float32) * s
    L, D = DEPTH, D_MODEL
    return {
        'x_prompt': nrm((BATCH, SEQ, D), 1.0),
        'x_sample': nrm((DEC_BATCH, DEC_SEQ, D), 1.0),
        'state_shift': nrm((L, DEC_BATCH, D), 1.0),
        'state_wkv': nrm((L, DEC_BATCH, N_HEADS, HEAD_SIZE, HEAD_SIZE), 0.3),
        'state_pool': nrm((L, DEC_BATCH, POOL_BUF, D_POOL), 1.0),
        'state_conv': nrm((L, DEC_BATCH, CONV_W - 1, 2 * D_FF), 1.0),
        'c_prompt': nrm((BATCH, D), 1.0),
        'c_sample': nrm((DEC_BATCH, D), 1.0),
        'ada_w': nrm((L, D, 6 * D), 0.2 * D ** -0.5),
        'ada_b': nrm((L, 6 * D), 0.02),
        'w_in': nrm((L, D, IN_COLS), D ** -0.5),
        'mu_shift': jax.random.uniform(next(ks), (L, D_SHIFT), jnp.float32),
        'decay_w0': jnp.linspace(-6.0, 1.0, D_RWKV, dtype=jnp.float32)[None, :] + nrm((L, D_RWKV), 0.1),
        'decay_up': nrm((L, D_DECAY_LORA, D_RWKV), 0.1 * D_DECAY_LORA ** -0.5),
        'aaa_a0': nrm((L, D_RWKV), 0.1),
        'aaa_up': nrm((L, D_AAA_LORA, D_RWKV), 0.5 * D_AAA_LORA ** -0.5),
        'gate_up': nrm((L, D_GATE_LORA, D_RWKV), D_GATE_LORA ** -0.5),
        'k_k': 0.85 + nrm((L, D_RWKV), 0.05),
        'k_a': 1.0 + nrm((L, D_RWKV), 0.05),
        'r_k': nrm((L, N_HEADS, HEAD_SIZE), 0.1),
        'gn_w': 1.0 + nrm((L, D_RWKV), 0.05),
        'gn_b': nrm((L, D_RWKV), 0.01),
        'w_branch_rwkv': nrm((L, D_RWKV, D), D_RWKV ** -0.5),
        'pool_w': nrm((L, N_POOL_GROUPS, POOL_GROUP, POOL_GROUP), POOL_GROUP ** -0.5),
        'pool_scale': 1.0 + nrm((L, D_POOL), 0.05),
        'w_branch_pool': nrm((L, D_POOL, D), D_POOL ** -0.5),
        'w_out': nrm((L, D, D), BETA * D ** -0.5),
        'ln1_w': 1.0 + nrm((L, D), 0.05),
        'ln1_b': nrm((L, D), 0.01),
        'ffn_up': nrm((L, D, 2 * D_FF), D ** -0.5),
        'conv_w': nrm((L, CONV_W, 2 * D_FF), CONV_W ** -0.5),
        'conv_b': nrm((L, 2 * D_FF), 0.01),
        'ffn_down': nrm((L, D_FF, D), BETA * D_FF ** -0.5),
        'ln2_w': 1.0 + nrm((L, D), 0.05),
        'ln2_b': nrm((L, D), 0.01),
    }


def reference(x_prompt, x_sample, state_shift, state_wkv, state_pool, state_conv, c_prompt, c_sample,
              ada_w, ada_b, w_in, mu_shift, decay_w0, decay_up, aaa_a0, aaa_up, gate_up, k_k, k_a, r_k,
              gn_w, gn_b, w_branch_rwkv, pool_w, pool_scale, w_branch_pool, w_out, ln1_w, ln1_b,
              ffn_up, conv_w, conv_b, ffn_down, ln2_w, ln2_b):
    p = {'ada_w': ada_w, 'ada_b': ada_b, 'w_in': w_in, 'mu_shift': mu_shift, 'decay_w0': decay_w0,
         'decay_up': decay_up, 'aaa_a0': aaa_a0, 'aaa_up': aaa_up, 'gate_up': gate_up, 'k_k': k_k,
         'k_a': k_a, 'r_k': r_k, 'gn_w': gn_w, 'gn_b': gn_b, 'w_branch_rwkv': w_branch_rwkv,
         'pool_w': pool_w, 'pool_scale': pool_scale, 'w_branch_pool': w_branch_pool, 'w_out': w_out,
         'ln1_w': ln1_w, 'ln1_b': ln1_b, 'ffn_up': ffn_up, 'conv_w': conv_w, 'conv_b': conv_b,
         'ffn_down': ffn_down, 'ln2_w': ln2_w, 'ln2_b': ln2_b}
    B = x_prompt.shape[0]
    f32 = jnp.float32
    z_shift = jnp.zeros((DEPTH, B, D_MODEL), f32)
    z_wkv = jnp.zeros((DEPTH, B, N_HEADS, HEAD_SIZE, HEAD_SIZE), f32)
    z_pool = jnp.zeros((DEPTH, B, POOL_BUF, D_POOL), f32)
    z_conv = jnp.zeros((DEPTH, B, CONV_W - 1, 2 * D_FF), f32)
    y_p, shift_p, wkv_p, pool_p, conv_p = run_trunk(x_prompt, c_prompt, 0, z_shift, z_wkv, z_pool, z_conv, p)
    y_s, shift_s, wkv_s, pool_s, conv_s = run_trunk(x_sample, c_sample, PAST_LEN, state_shift, state_wkv,
                                                    state_pool, state_conv, p)
    dt = x_prompt.dtype
    return (y_p.astype(dt), y_s.astype(dt), shift_p.astype(dt), wkv_p.astype(dt), pool_p.astype(dt),
            conv_p.astype(dt), shift_s.astype(dt), wkv_s.astype(dt), pool_s.astype(dt), conv_s.astype(dt))
```

```cpp
#include <hip/hip_runtime.h>
#include <hip/hip_cooperative_groups.h>
#include <cstdio>
#include <cstdint>
namespace cg = cooperative_groups;
namespace pg8 {
#define PG8_LAS __attribute__((address_space(3)))
typedef unsigned short bf16_t;
typedef short bf16x8 __attribute__((ext_vector_type(8)));
typedef float f32x4 __attribute__((ext_vector_type(4)));
typedef unsigned u32x4 __attribute__((ext_vector_type(4)));
constexpr int BM = 256, BK = 64, HALF = 128, HTB = HALF * BK * 2  , STAGE_BYTES = 8 * HTB, NXCD = 8, WGM = 8;

__host__ __device__ __forceinline__ int lds_byte(int r, int c) { const int st = (r >> 4) * 2 + (c >> 5), rr = r & 15, cc = c & 31, ob = rr * 64 + cc * 2; return st * 1024 + (ob ^ (((ob >> 9) & 1) << 5)); }
__host__ __device__ __forceinline__ void stage_rc(int b, int& R, int& C) { const int st = b / 1024, sb = b % 1024, swz = sb ^ (((sb >> 9) & 1) << 5); R = (st >> 1) * 16 + swz / 64; C = (st & 1) * 32 + (swz % 64) / 2; }
__host__ __device__ __forceinline__ int perm32(int rho) { const int n = rho >> 4, i = rho & 15; return 8 * (i >> 2) + 4 * n + (i & 3); }

struct Unit { int pm, pn; };
struct Gemm { const bf16_t* A; const bf16_t* Bt; int M, N, K; };

struct StaticOrder {
    int nM, nN, nwg, G, c;
    __host__ __device__ void init(int M, int N, int G_, int c_) { nM = M / BM; nN = N / BM; nwg = nM * nN; G = G_; c = c_; }
    __host__ __device__ bool next(int i, Unit& u) const {
        const long L = (long)i * G + c; if (L >= nwg) return false;
        int wgid = (int)L; { const int q = nwg / NXCD, r = nwg % NXCD, xcd = wgid % NXCD, off = wgid / NXCD; wgid = (xcd < r ? xcd * (q + 1) : r * (q + 1) + (xcd - r) * q) + off; }
        const int nig = WGM * nN, gid = wgid / nig, fm = gid * WGM, gsz = (nM - fm) < WGM ? (nM - fm) : WGM;
        u.pm = fm + ((wgid % nig) % gsz); u.pn = (wgid % nig) / gsz; return true;
    }
    __device__ __forceinline__ void a_ready(const Unit&) const {}
    __device__ __forceinline__ void done(const Unit&) const {}
};

__device__ __forceinline__ unsigned cvt_pk_bf16(float lo, float hi) { unsigned r; asm volatile("v_cvt_pk_bf16_f32 %0, %1, %2" : "=v"(r) : "v"(lo), "v"(hi)); return r; }
typedef float f32x2 __attribute__((ext_vector_type(2)));
__device__ __forceinline__ f32x2 gelu_pk(f32x2 v) {
    const f32x2 av = __builtin_elementwise_abs(v), d = av * 0.2316418882f + 1.0f;
    f32x2 t; t.x = __builtin_amdgcn_rcpf(d.x); t.y = __builtin_amdgcn_rcpf(d.y);
    f32x2 q = t * 0.5307027145f + (-0.7265760135f); q = q * t + 0.7107068705f; q = q * t + (-0.142248368f); q = q * t + 0.127414796f; q = q * t;
    const f32x2 s = (v * v) * (-0.72134752044f);
    f32x2 e; e.x = __builtin_amdgcn_exp2f(s.x); e.y = __builtin_amdgcn_exp2f(s.y);
    const f32x2 m = v * (q * e), r = v - m;
    f32x2 o; o.x = v.x < 0.f ? m.x : r.x; o.y = v.y < 0.f ? m.y : r.y; return o;
}

template <int ACT  > struct EpiBf16 {
    static constexpr bool PERM = true, AFTER_DRAIN = false; static_assert(ACT == 0 || ACT == 1, "EpiBf16: ACT is 0 (none) or 1 (gelu_pk)");
    bf16_t* O; int ldc; const float* bias; int split_cols; size_t split_stride; float scale0;
    __device__ __forceinline__ void operator()(const f32x4 (&acc)[2][2][4][2], const Unit& u, int wr, int wc, int fr, int fq) const {
        const int row0 = u.pm * BM + wr * 64 + fr; int colt = u.pn * BM; bf16_t* base = O;
        float sc = 1.f; if (split_cols) { const int t = colt / split_cols; base += (size_t)t * split_stride; colt -= t * split_cols; if (t == 0) sc = scale0; }
        const int col0 = colt + wc * 32 + 8 * fq, bcol0 = u.pn * BM + wc * 32 + 8 * fq;
        f32x4 bv[2][2];
#pragma unroll
        for (int bj = 0; bj < 2; ++bj)
#pragma unroll
            for (int n = 0; n < 2; ++n) bv[bj][n] = bias ? *(const f32x4*)(bias + bcol0 + bj * HALF + 4 * n) : (f32x4){0.f, 0.f, 0.f, 0.f};
#pragma unroll
        for (int ai = 0; ai < 2; ++ai)
#pragma unroll
            for (int m = 0; m < 4; ++m) { bf16_t* rowp = base + (size_t)(row0 + ai * HALF + m * 16) * ldc + col0;
#pragma unroll
                for (int bj = 0; bj < 2; ++bj) { f32x4 v0 = acc[ai][bj][m][0] + bv[bj][0], v1 = acc[ai][bj][m][1] + bv[bj][1];
                    if (ACT == 1) { f32x2 a = gelu_pk((f32x2){v0[0], v0[1]}), b = gelu_pk((f32x2){v0[2], v0[3]}), c = gelu_pk((f32x2){v1[0], v1[1]}), d = gelu_pk((f32x2){v1[2], v1[3]});
                        v0 = (f32x4){a.x, a.y, b.x, b.y}; v1 = (f32x4){c.x, c.y, d.x, d.y}; }
                    v0 = v0 * sc; v1 = v1 * sc; u32x4 w; w.x = cvt_pk_bf16(v0[0], v0[1]); w.y = cvt_pk_bf16(v0[2], v0[3]); w.z = cvt_pk_bf16(v1[0], v1[1]); w.w = cvt_pk_bf16(v1[2], v1[3]);
                    *(u32x4*)(rowp + bj * HALF) = w; } }
    }
};

struct PanelStats {
    unsigned* xbuf;
    unsigned* cnt;
    unsigned* tmo;
    int ntn; float eps;
    unsigned code;
    __device__ __forceinline__ bool run(const f32x4 (&v)[2][2][4][2], const Unit& u, int wr, int wc, int fr, int fq, PG8_LAS unsigned char* lds, int wid, int lane) const {
        typedef float f32x2v __attribute__((ext_vector_type(2)));
        PG8_LAS f32x2v* P = (PG8_LAS f32x2v*)lds;
        PG8_LAS f32x2v* S = (PG8_LAS f32x2v*)(lds + 8192);
        PG8_LAS unsigned* flag = (PG8_LAS unsigned*)(lds + 8192 + 2048);
#pragma unroll
        for (int ai = 0; ai < 2; ++ai)
#pragma unroll
            for (int m = 0; m < 4; ++m) {
                float s = 0.f;
#pragma unroll
                for (int bj = 0; bj < 2; ++bj)
#pragma unroll
                    for (int n = 0; n < 2; ++n) { const f32x4 x = v[ai][bj][m][n]; s += (x[0] + x[1]) + (x[2] + x[3]); }
                s += __shfl_xor(s, 16); s += __shfl_xor(s, 32);
                const float mw = s * (1.0f / 64.0f); float q = 0.f;
#pragma unroll
                for (int bj = 0; bj < 2; ++bj)
#pragma unroll
                    for (int n = 0; n < 2; ++n) { const f32x4 d = v[ai][bj][m][n] - mw; q += (d[0] * d[0] + d[1] * d[1]) + (d[2] * d[2] + d[3] * d[3]); }
                q += __shfl_xor(q, 16); q += __shfl_xor(q, 32);
                if (fq == 0) P[(ai * HALF + wr * 64 + m * 16 + fr) * 4 + wc] = (f32x2v){mw, q};
            }
        asm volatile("s_waitcnt lgkmcnt(0)" ::: "memory"); __builtin_amdgcn_s_barrier(); asm volatile("" ::: "memory");
#if defined(BROKEN_EXCHANGE_NO_WAIT)
#warning BROKEN CONTROL BUILD: the row-statistics exchange does not wait; results are wrong by design
        if (blockIdx.x >= 64) { const long long t0_ = clock64(); while (clock64() - t0_ < 60000) __builtin_amdgcn_s_sleep(8); }
#endif
        const int row = wid * 32 + (lane & 31);
        if (lane < 32) {
            const f32x2v a = P[row * 4 + 0], b = P[row * 4 + 1], c = P[row * 4 + 2], d = P[row * 4 + 3];
            const float mt = (a.x + b.x + c.x + d.x) * 0.25f;
            const float da = a.x - mt, db = b.x - mt, dc = c.x - mt, dd = d.x - mt;
            const float m2 = (a.y + b.y) + (c.y + d.y) + 64.0f * ((da * da + db * db) + (dc * dc + dd * dd));
            unsigned long long* slot = (unsigned long long*)xbuf + ((size_t)(u.pm * BM + row) * 4 + u.pn);
            __hip_atomic_store(slot, ((unsigned long long)__float_as_uint(m2) << 32) | __float_as_uint(mt), __ATOMIC_RELAXED, __HIP_MEMORY_SCOPE_AGENT);
        }
        asm volatile("s_waitcnt vmcnt(0)" ::: "memory");
        if (lane == 0) __hip_atomic_fetch_add(cnt + 64 * u.pm, 1u, __ATOMIC_RELAXED, __HIP_MEMORY_SCOPE_AGENT);
        if (wid == 0) {
            bool dead = false; const unsigned long long t0 = __builtin_amdgcn_s_memrealtime(); const unsigned want = 8u * (unsigned)ntn;
            for (;;) {
#if defined(BROKEN_EXCHANGE_NO_WAIT)
                break;
#endif
                if ((unsigned)__builtin_amdgcn_readfirstlane(__hip_atomic_load(cnt + 64 * u.pm, __ATOMIC_RELAXED, __HIP_MEMORY_SCOPE_AGENT)) >= want) break;
                if (__builtin_amdgcn_s_memrealtime() - t0 > 2000000ull) {
                    if (lane == 0) { unsigned expect = 0u; __hip_atomic_compare_exchange_strong(tmo + 1, &expect, code | (unsigned)(u.pm & 0xff), __ATOMIC_RELAXED, __ATOMIC_RELAXED, __HIP_MEMORY_SCOPE_AGENT);
                                     __hip_atomic_store(tmo, 1u, __ATOMIC_RELAXED, __HIP_MEMORY_SCOPE_AGENT); }
                    dead = true; break; }
                __builtin_amdgcn_s_sleep(2);
            }
            __builtin_amdgcn_fence(__ATOMIC_ACQUIRE, "agent");
            if (lane == 0) flag[0] = dead ? 1u : 0u;
        }
        asm volatile("s_waitcnt vmcnt(0) lgkmcnt(0)" ::: "memory"); __builtin_amdgcn_s_barrier(); asm volatile("" ::: "memory");
        const bool bad = flag[0] != 0u;
        if (lane < 32) {
            const unsigned long long* slot = (const unsigned long long*)xbuf + (size_t)(u.pm * BM + row) * 4; float mt[4], m2[4]; float ms = 0.f;
#pragma unroll
            for (int t = 0; t < 4; ++t) { if (t < ntn) { const unsigned long long w = __hip_atomic_load(slot + t, __ATOMIC_RELAXED, __HIP_MEMORY_SCOPE_AGENT); mt[t] = __uint_as_float((unsigned)w); m2[t] = __uint_as_float((unsigned)(w >> 32)); } else { mt[t] = 0.f; m2[t] = 0.f; } ms += mt[t]; }
            const float mean = ms / (float)ntn; float q = 0.f;
#pragma unroll
            for (int t = 0; t < 4; ++t) if (t < ntn) { const float dm = mt[t] - mean; q += m2[t] + 256.0f * dm * dm; }
            S[row] = (f32x2v){mean, 1.0f / sqrtf(q / (256.0f * (float)ntn) + eps)};
        }
        asm volatile("s_waitcnt lgkmcnt(0)" ::: "memory"); __builtin_amdgcn_s_barrier(); asm volatile("" ::: "memory");
        return bad;
    }
};
struct EpiLnRes {
    static constexpr bool PERM = false, AFTER_DRAIN = true;
    const float* base; float* out; int ldc; const float* bias; PanelStats st; unsigned poison;
    __device__ __forceinline__ void fused(f32x4 (&acc)[2][2][4][2], const Unit& u, int wr, int wc, int fr, int fq, PG8_LAS unsigned char* lds, int wid, int lane) const {
        typedef float f32x2v __attribute__((ext_vector_type(2)));
        const PG8_LAS f32x2v* S = (const PG8_LAS f32x2v*)(lds + 8192);
        const int col0 = u.pn * BM + wc * 32 + 4 * fq;
#pragma unroll
        for (int bj = 0; bj < 2; ++bj)
#pragma unroll
            for (int n = 0; n < 2; ++n) { const f32x4 bv = bias ? *(const f32x4*)(bias + col0 + bj * HALF + n * 16) : (f32x4){0.f, 0.f, 0.f, 0.f};
#pragma unroll
                for (int ai = 0; ai < 2; ++ai)
#pragma unroll
                    for (int m = 0; m < 4; ++m) acc[ai][bj][m][n] += bv; }
        f32x4 pre[4][2][2];
#pragma unroll
        for (int m = 0; m < 4; ++m) { const size_t off = (size_t)(u.pm * BM + wr * 64 + m * 16 + fr) * ldc + col0;
#pragma unroll
            for (int bj = 0; bj < 2; ++bj)
#pragma unroll
                for (int n = 0; n < 2; ++n) pre[m][bj][n] = *(const f32x4*)(base + off + bj * HALF + n * 16); }
        const bool bad = st.run(acc, u, wr, wc, fr, fq, lds, wid, lane) || poison != 0u;
        const float qnan = __builtin_nanf("");
#pragma unroll
        for (int ai = 0; ai < 2; ++ai)
#pragma unroll
            for (int m = 0; m < 4; ++m) { const int r = ai * HALF + wr * 64 + m * 16 + fr; const f32x2v sr = S[r]; const size_t off = (size_t)(u.pm * BM + r) * ldc + col0;
#pragma unroll
                for (int bj = 0; bj < 2; ++bj)
#pragma unroll
                    for (int n = 0; n < 2; ++n) { const f32x4 bs = ai == 0 ? pre[m][bj][n] : *(const f32x4*)(base + off + bj * HALF + n * 16); f32x4 o = bs + (acc[ai][bj][m][n] - sr.x) * sr.y;
                        if (bad) o = (f32x4){qnan, qnan, qnan, qnan}; *(f32x4*)(out + off + bj * HALF + n * 16) = o; }
                if (m & 1) asm volatile("" ::: "memory"); }
    }
};
struct EpiLnResLn {
    static constexpr bool PERM = false, AFTER_DRAIN = true;
    const float* base; float* out; bf16_t* xn; int ldc; const float* bias; PanelStats st1, st2; unsigned poison;
    __device__ __forceinline__ void fused(f32x4 (&acc)[2][2][4][2], const Unit& u, int wr, int wc, int fr, int fq, PG8_LAS unsigned char* lds, int wid, int lane) const {
        typedef float f32x2v __attribute__((ext_vector_type(2))); typedef unsigned u32x2v __attribute__((ext_vector_type(2)));
        const PG8_LAS f32x2v* S = (const PG8_LAS f32x2v*)(lds + 8192);
        const int col0 = u.pn * BM + wc * 32 + 4 * fq;
#pragma unroll
        for (int bj = 0; bj < 2; ++bj)
#pragma unroll
            for (int n = 0; n < 2; ++n) { const f32x4 bv = bias ? *(const f32x4*)(bias + col0 + bj * HALF + n * 16) : (f32x4){0.f, 0.f, 0.f, 0.f};
#pragma unroll
                for (int ai = 0; ai < 2; ++ai)
#pragma unroll
                    for (int m = 0; m < 4; ++m) acc[ai][bj][m][n] += bv; }
        bool bad = st1.run(acc, u, wr, wc, fr, fq, lds, wid, lane) || poison != 0u;
        const float qnan = __builtin_nanf("");
#pragma unroll
        for (int ai = 0; ai < 2; ++ai)
#pragma unroll
            for (int m = 0; m < 4; ++m) { const int r = ai * HALF + wr * 64 + m * 16 + fr; const f32x2v sr = S[r]; const size_t off = (size_t)(u.pm * BM + r) * ldc + col0;
#pragma unroll
                for (int bj = 0; bj < 2; ++bj)
#pragma unroll
                    for (int n = 0; n < 2; ++n) { const f32x4 bs = *(const f32x4*)(base + off + bj * HALF + n * 16); acc[ai][bj][m][n] = bs + (acc[ai][bj][m][n] - sr.x) * sr.y; }
                asm volatile("" : "+v"(acc[ai][0][m][0]), "+v"(acc[ai][0][m][1]), "+v"(acc[ai][1][m][0]), "+v"(acc[ai][1][m][1]));
                if (m & 1) asm volatile("" ::: "memory"); }
        const bool bad1 = bad;
        bad = st2.run(acc, u, wr, wc, fr, fq, lds, wid, lane) || bad;
#pragma unroll
        for (int ai = 0; ai < 2; ++ai)
#pragma unroll
            for (int m = 0; m < 4; ++m) { const int r = ai * HALF + wr * 64 + m * 16 + fr; const f32x2v sr = S[r]; const size_t off = (size_t)(u.pm * BM + r) * ldc + col0;
#pragma unroll
                for (int bj = 0; bj < 2; ++bj)
#pragma unroll
                    for (int n = 0; n < 2; ++n) { const f32x4 x1 = acc[ai][bj][m][n]; *(f32x4*)(out + off + bj * HALF + n * 16) = bad1 ? (f32x4){qnan, qnan, qnan, qnan} : x1;
                        const f32x4 o = (x1 - sr.x) * sr.y; u32x2v w; w.x = cvt_pk_bf16(o[0], o[1]); w.y = cvt_pk_bf16(o[2], o[3]);
                        if (bad) { w.x = 0x7fc07fc0u; w.y = 0x7fc07fc0u; } *(u32x2v*)(xn + off + bj * HALF + n * 16) = w; }
                asm volatile("" ::: "memory"); }
    }
};

template <class Epi, class Sched, bool ALIGN_EPI = false, bool SP2 = false>
__device__ __forceinline__ void gemm_phase(PG8_LAS unsigned char* lds, const Gemm g, const Sched& S, const Epi& E) {
    int tid_ = threadIdx.x; asm volatile("" : "+v"(tid_));
    const int tid = tid_, wid = __builtin_amdgcn_readfirstlane(tid >> 6), lane = tid & 63, wr = wid >> 2, wc = wid & 3, fr = lane & 15, fq = lane >> 4;
    const int K = g.K, nt = K / BK;
    unsigned voffA[2], voffB[2];
#pragma unroll
    for (int i = 0; i < 2; ++i) { int R, C; stage_rc(tid * 16 + i * 8192, R, C); const int Rb = Epi::PERM ? ((R & ~31) + perm32(R & 31)) : R;
        voffA[i] = (unsigned)(R * K + C) * 2u; voffB[i] = (unsigned)(Rb * K + C) * 2u; }
    const size_t kstep = (size_t)(BK * 2);
    const size_t hstep = (size_t)HALF * K * 2;
    const size_t tstep = 2 * hstep;
    const unsigned ldsw = (unsigned)wid * 1024u;
    const int aoff = lds_byte(wr * 64 + fr, fq * 8), boff = lds_byte(wc * 32 + fr, fq * 8);
#define PG8_SA(b, h) (((b) * 2 + (h)) * HTB)
#define PG8_SB(b, h) ((4 + (b) * 2 + (h)) * HTB)
#define PG8_STAGE(bufoff, gbase, voff) do { _Pragma("unroll") for (int _i = 0; _i < 2; ++_i) \
        __builtin_amdgcn_global_load_lds((const unsigned*)((const char*)(gbase) + (voff)[_i]), (PG8_LAS unsigned*)(lds + (bufoff) + ldsw + _i * 8192), 16, 0, 0); } while (0)
#define PG8_LDA(dst, b, h) do { _Pragma("unroll") for (int m = 0; m < 4; ++m) _Pragma("unroll") for (int k = 0; k < 2; ++k) dst[m][k] = *(const PG8_LAS bf16x8*)(lds + PG8_SA(b, h) + aoff + m * 2048 + k * 1024); } while (0)
#define PG8_LDB(dst, b, h) do { _Pragma("unroll") for (int n = 0; n < 2; ++n) _Pragma("unroll") for (int k = 0; k < 2; ++k) dst[n][k] = *(const PG8_LAS bf16x8*)(lds + PG8_SB(b, h) + boff + n * 2048 + k * 1024); } while (0)
#define PG8_MMA(ai, bj, At, Bt) do { __builtin_amdgcn_s_setprio(1); _Pragma("unroll") for (int m = 0; m < 4; ++m) _Pragma("unroll") for (int n = 0; n < 2; ++n) _Pragma("unroll") for (int k = 0; k < 2; ++k) \
        acc[ai][bj][m][n] = __builtin_amdgcn_mfma_f32_16x16x32_bf16(Bt[n][k], At[m][k], acc[ai][bj][m][n], 0, 0, 0); __builtin_amdgcn_s_setprio(0); } while (0)
#define PG8_WAIT_V(n) asm volatile("s_waitcnt vmcnt(" #n ")" ::: "memory")
#define PG8_WAIT_L(n) asm volatile("s_waitcnt lgkmcnt(" #n ")" ::: "memory")
#define PG8_BAR __builtin_amdgcn_s_barrier()
#define PG8_SCHED __builtin_amdgcn_sched_barrier(0)
    Unit cur, nxt; int ui = 0;
    if (!S.next(0, cur)) return;
    f32x4 acc[2][2][4][2];
#pragma unroll
    for (int a = 0; a < 2; ++a)
#pragma unroll
        for (int b = 0; b < 2; ++b)
#pragma unroll
            for (int m = 0; m < 4; ++m)
#pragma unroll
                for (int n = 0; n < 2; ++n) acc[a][b][m][n] = (f32x4){0.f, 0.f, 0.f, 0.f};
    bf16x8 At[4][2], B0[2][2], B1[2][2];
    const char* cA = (const char*)g.A + (size_t)cur.pm * tstep; const char* cB = (const char*)g.Bt + (size_t)cur.pn * tstep;
    S.a_ready(cur);
    if constexpr (SP2) {
        PG8_STAGE(PG8_SB(0, 0), cB, voffB); PG8_STAGE(PG8_SB(0, 1), cB + hstep, voffB); PG8_STAGE(PG8_SA(0, 0), cA, voffA); PG8_STAGE(PG8_SA(0, 1), cA + hstep, voffA);
        if (wr == 1) PG8_BAR;
        PG8_WAIT_V(2); PG8_BAR;
        PG8_STAGE(PG8_SB(1, 0), cB + kstep, voffB); PG8_STAGE(PG8_SA(1, 0), cA + kstep, voffA); PG8_STAGE(PG8_SB(1, 1), cB + hstep + kstep, voffB);
        PG8_WAIT_V(6); PG8_BAR;
    } else {
        PG8_STAGE(PG8_SB(0, 0), cB, voffB); PG8_STAGE(PG8_SA(0, 0), cA, voffA); PG8_STAGE(PG8_SB(0, 1), cB + hstep, voffB); PG8_STAGE(PG8_SA(0, 1), cA + hstep, voffA);
        if (wr == 1) PG8_BAR;
        PG8_WAIT_V(4); PG8_BAR;
        PG8_STAGE(PG8_SB(1, 0), cB + kstep, voffB); PG8_STAGE(PG8_SA(1, 0), cA + kstep, voffA); PG8_STAGE(PG8_SB(1, 1), cB + hstep + kstep, voffB);
        PG8_WAIT_V(6); PG8_BAR;
    }
    for (;;) {
        const bool has_next = S.next(ui + 1, nxt);
        const char* nA = has_next ? (const char*)g.A + (size_t)nxt.pm * tstep : cA; const char* nB = has_next ? (const char*)g.Bt + (size_t)nxt.pn * tstep : cB;
        for (int t = 0; t < nt; t += 2) {
            const bool last = (t == nt - 2);
            const char* a1 = cA + (size_t)(t + 1) * kstep;
            const char* a2 = last ? nA : cA + (size_t)(t + 2) * kstep; const char* b2 = last ? nB : cB + (size_t)(t + 2) * kstep;
            const char* a3 = a2 + kstep; const char* b3 = b2 + kstep;
            if (last && has_next) S.a_ready(nxt);
            if constexpr (SP2) {
            PG8_LDB(B0, 0, 0); PG8_LDB(B1, 0, 1); PG8_SCHED; PG8_LDA(At, 0, 0); PG8_STAGE(PG8_SA(1, 1), a1 + hstep, voffA);
            PG8_WAIT_V(8); PG8_WAIT_L(0); PG8_BAR; PG8_MMA(0, 0, At, B0); PG8_MMA(0, 1, At, B1); PG8_BAR; PG8_SCHED;
            PG8_LDA(At, 0, 1); PG8_STAGE(PG8_SB(0, 0), b2, voffB); PG8_STAGE(PG8_SB(0, 1), b2 + hstep, voffB); PG8_STAGE(PG8_SA(0, 0), a2, voffA);
            PG8_WAIT_V(8); PG8_WAIT_L(0); PG8_BAR; PG8_MMA(1, 0, At, B0); PG8_MMA(1, 1, At, B1); PG8_BAR; PG8_SCHED;
            PG8_LDB(B0, 1, 0); PG8_LDB(B1, 1, 1); PG8_SCHED; PG8_LDA(At, 1, 0); PG8_STAGE(PG8_SA(0, 1), a2 + hstep, voffA);
            PG8_WAIT_V(8); PG8_WAIT_L(0); PG8_BAR; PG8_MMA(0, 0, At, B0); PG8_MMA(0, 1, At, B1); PG8_BAR; PG8_SCHED;
            PG8_LDA(At, 1, 1); PG8_STAGE(PG8_SB(1, 0), b3, voffB); PG8_STAGE(PG8_SB(1, 1), b3 + hstep, voffB); PG8_STAGE(PG8_SA(1, 0), a3, voffA);
            PG8_WAIT_V(8); PG8_WAIT_L(0); PG8_BAR; PG8_MMA(1, 0, At, B0); PG8_MMA(1, 1, At, B1); PG8_BAR; PG8_SCHED;
            } else {
            PG8_LDB(B0, 0, 0); PG8_SCHED; PG8_LDA(At, 0, 0); PG8_STAGE(PG8_SA(1, 1), a1 + hstep, voffA);
            PG8_WAIT_L(8); PG8_BAR; PG8_WAIT_L(0); PG8_MMA(0, 0, At, B0); PG8_BAR; PG8_SCHED;
            PG8_LDB(B1, 0, 1); PG8_STAGE(PG8_SB(0, 0), b2, voffB);
            PG8_BAR; PG8_WAIT_L(0); PG8_MMA(0, 1, At, B1); PG8_BAR;
            PG8_LDA(At, 0, 1); PG8_STAGE(PG8_SA(0, 0), a2, voffA);
            PG8_BAR; PG8_WAIT_L(0); PG8_MMA(1, 0, At, B0); PG8_BAR; PG8_SCHED;
            PG8_STAGE(PG8_SB(0, 1), b2 + hstep, voffB);
            PG8_WAIT_V(6); PG8_BAR; PG8_MMA(1, 1, At, B1); PG8_BAR;
            PG8_LDB(B0, 1, 0); PG8_SCHED; PG8_LDA(At, 1, 0); PG8_STAGE(PG8_SA(0, 1), a2 + hstep, voffA);
            PG8_WAIT_L(8); PG8_BAR; PG8_WAIT_L(0); PG8_MMA(0, 0, At, B0); PG8_BAR; PG8_SCHED;
            PG8_LDB(B1, 1, 1); PG8_STAGE(PG8_SB(1, 0), b3, voffB);
            PG8_BAR; PG8_WAIT_L(0); PG8_MMA(0, 1, At, B1); PG8_BAR;
            PG8_LDA(At, 1, 1); PG8_STAGE(PG8_SA(1, 0), a3, voffA);
            PG8_BAR; PG8_WAIT_L(0); PG8_MMA(1, 0, At, B0); PG8_BAR; PG8_SCHED;
            PG8_STAGE(PG8_SB(1, 1), b3 + hstep, voffB);
            PG8_WAIT_V(6); PG8_BAR; PG8_MMA(1, 1, At, B1); PG8_BAR;
            }
        }
        if constexpr (ALIGN_EPI) { if (wr == 0) PG8_BAR; }
        if constexpr (!Epi::AFTER_DRAIN) { E(acc, cur, wr, wc, fr, fq); S.done(cur); }
        if (!has_next) break;
#pragma unroll
        for (int a = 0; a < 2; ++a)
#pragma unroll
            for (int b = 0; b < 2; ++b)
#pragma unroll
                for (int m = 0; m < 4; ++m)
#pragma unroll
                    for (int n = 0; n < 2; ++n) acc[a][b][m][n] = (f32x4){0.f, 0.f, 0.f, 0.f};
        cur = nxt; cA = nA; cB = nB; ++ui;
        if constexpr (ALIGN_EPI) { if (wr == 1) PG8_BAR; }
    }
    PG8_WAIT_V(0);
    if constexpr (!ALIGN_EPI) { if (wr == 0) PG8_BAR; }
    PG8_BAR;
    if constexpr (Epi::AFTER_DRAIN) { E.fused(acc, cur, wr, wc, fr, fq, lds, wid, lane); S.done(cur); }
#undef PG8_SA
#undef PG8_SB
#undef PG8_STAGE
#undef PG8_LDA
#undef PG8_LDB
#undef PG8_MMA
#undef PG8_WAIT_V
#undef PG8_WAIT_L
#undef PG8_BAR
#undef PG8_SCHED
}
}
#define LAS __attribute__((address_space(3)))
typedef unsigned short bf16;
typedef float f32x4 __attribute__((ext_vector_type(4)));
typedef unsigned u32x4 __attribute__((ext_vector_type(4)));
typedef unsigned u32x2 __attribute__((ext_vector_type(2)));

constexpr int D = 1024, NB = 8, SEQ = 2048, NL = 2, DECB = 128, NH = 16, HS = 64;
constexpr int DPOOL = 512, PBUF = 15, DFF = 2816, FF2 = 5632, INC = 5888;
constexpr int MP = NB * SEQ, MT = MP + DECB, MPAD = 16640;
constexpr int C_R = 0, C_K = 1024, C_V = 2048, C_WL = 3072, C_POOL = 3328, C_GP = 3840, C_GR = 4864;
constexpr int NMOD = 6 * D, NMOD2 = NL * NMOD;
constexpr float ALPHA = 1.41421356237309515f;
constexpr float LN_EPS = 1e-5f, GN_EPS = 64e-5f;
constexpr int NWAVES = 8, NTHR = 512;

constexpr size_t O_YP = 0, O_YS = 16777216, O_SHP = 16908288, O_WKVP = 16924672, O_POOLP = 17973248, O_CONVP = 18096128,
                 O_SHS = 18276352, O_WKVS = 18538496, O_POOLS = 35315712, O_CONVS = 37281792, O_END = 40165376;

enum { I_XP = 0, I_XS, I_SSHIFT, I_SWKV, I_SPOOL, I_SCONV, I_CP, I_CS, I_ADAW, I_ADAB, I_WIN, I_MU, I_DW0, I_DUP, I_A0, I_AUP, I_GUP,
       I_KK, I_KA, I_RK, I_GNW, I_GNB, I_WBR, I_PW, I_PS, I_WBP, I_WOUT, I_LN1W, I_LN1B, I_UP, I_CW, I_CB, I_DOWN, I_LN2W, I_LN2B, N_IN };

constexpr size_t MiB = 1u << 20;
constexpr size_t SZ_WIN = (size_t)INC * D * 2, SZ_LORA = (size_t)3072 * 256 * 2, SZ_WBR = (size_t)D * D * 2, SZ_PW = (size_t)512 * 512 * 2,
                 SZ_WBP = (size_t)D * 512 * 2, SZ_WOUT = (size_t)D * D * 2, SZ_UP = (size_t)FF2 * D * 2, SZ_DOWN = (size_t)D * DFF * 2;
constexpr size_t WS_WIN = 1 * MiB, WS_LORA = WS_WIN + NL * SZ_WIN, WS_WBR = WS_LORA + NL * SZ_LORA, WS_PW = WS_WBR + NL * SZ_WBR,
                 WS_WBP = WS_PW + NL * SZ_PW, WS_WOUT = WS_WBP + NL * SZ_WBP, WS_UP = WS_WOUT + NL * SZ_WOUT, WS_DOWN = WS_UP + NL * SZ_UP,
                 WS_LBIAS = WS_DOWN + NL * SZ_DOWN, WS_CALL = WS_LBIAS + NL * 3072 * 4, WS_MOD = WS_CALL + 256 * D * 2,
                 WS_RK = WS_MOD + (size_t)256 * NMOD2 * 4, WS_H = WS_RK + (size_t)MPAD * 16 * 4, WS_PROJ = WS_H + (size_t)MPAD * D * 2,
                 WS_AL = WS_PROJ + (size_t)MPAD * INC * 2, WS_PD = WS_AL + (size_t)MPAD * 256 * 2, WS_LO = WS_PD + (size_t)MPAD * 512 * 2,
                 WS_PM = WS_LO + (size_t)MPAD * 3072 * 2, WS_Y = WS_PM + (size_t)MPAD * 512 * 2, WS_END = WS_Y + (size_t)MPAD * D * 2;
constexpr size_t WS_ADA = WS_LO, WS_MG = WS_LO, WS_ACT = WS_LO, WS_U = WS_PROJ;
static_assert((size_t)NMOD2 * D * 2 <= (size_t)MPAD * 3072 * 2 && (size_t)MPAD * DFF * 2 <= (size_t)MPAD * 3072 * 2 && (size_t)MPAD * FF2 * 2 <= (size_t)MPAD * INC * 2, "overlays fit");
static_assert(WS_END <= 512 * MiB, "workspace map fits 512 MiB");

constexpr int LDS_BYTES = 147456;

struct Args { const float* in[N_IN]; float* out; unsigned char* ws; int ph_lo, ph_hi; };
typedef const __attribute__((address_space(4))) Args* KArgs;
__device__ __forceinline__ int opqv(int x) { asm volatile("" : "+v"(x)); return x; }
__device__ __forceinline__ int opq(int x) { asm volatile("" : "+s"(x)); return x; }
__device__ __forceinline__ KArgs fresh_args() { KArgs p = (KArgs)__builtin_amdgcn_kernarg_segment_ptr(); asm volatile("" : "+s"(p)); return p; }

__device__ __forceinline__ float bflo(unsigned u) { return __uint_as_float(u << 16); }
__device__ __forceinline__ float bfhi(unsigned u) { return __uint_as_float(u & 0xffff0000u); }
__device__ __forceinline__ float bf1(bf16 b) { return __uint_as_float((unsigned)b << 16); }
__device__ __forceinline__ unsigned pk2(float lo, float hi) { return pg8::cvt_pk_bf16(lo, hi); }
struct f8 { f32x4 a, b; };
__device__ __forceinline__ f8 unpack8(u32x4 v) { f8 r; r.a = (f32x4){bflo(v.x), bfhi(v.x), bflo(v.y), bfhi(v.y)}; r.b = (f32x4){bflo(v.z), bfhi(v.z), bflo(v.w), bfhi(v.w)}; return r; }
__device__ __forceinline__ u32x4 pack8(f8 x) { u32x4 r; r.x = pk2(x.a.x, x.a.y); r.y = pk2(x.a.z, x.a.w); r.z = pk2(x.b.x, x.b.y); r.w = pk2(x.b.z, x.b.w); return r; }
__device__ __forceinline__ f8 ld8f(const float* p) { f8 r; r.a = *(const f32x4*)p; r.b = *(const f32x4*)(p + 4); return r; }
__device__ __forceinline__ f8 ld8b(const bf16* p) { return unpack8(*(const u32x4*)p); }
__device__ __forceinline__ f8 zero8() { f8 r; r.a = (f32x4){0.f, 0.f, 0.f, 0.f}; r.b = r.a; return r; }
__device__ __forceinline__ f8 add8(f8 x, f8 y) { f8 r; r.a = x.a + y.a; r.b = x.b + y.b; return r; }
__device__ __forceinline__ f8 sub8(f8 x, f8 y) { f8 r; r.a = x.a - y.a; r.b = x.b - y.b; return r; }
__device__ __forceinline__ f8 mul8(f8 x, f8 y) { f8 r; r.a = x.a * y.a; r.b = x.b * y.b; return r; }
__device__ __forceinline__ f8 scl8(f8 x, float s) { f8 r; r.a = x.a * s; r.b = x.b * s; return r; }
__device__ __forceinline__ f8 mix8(f8 cur, f8 prev, f8 mu) { f8 r; r.a = cur.a + (prev.a - cur.a) * mu.a; r.b = cur.b + (prev.b - cur.b) * mu.b; return r; }
__device__ __forceinline__ float hsum4(f32x4 v) { return (v.x + v.y) + (v.z + v.w); }
__device__ __forceinline__ float hsum8(f8 v) { return hsum4(v.a) + hsum4(v.b); }
__device__ __forceinline__ float sigm(float x) { return __builtin_amdgcn_rcpf(1.0f + __expf(-x)); }
__device__ __forceinline__ f32x4 sigm4(f32x4 v) { return (f32x4){sigm(v.x), sigm(v.y), sigm(v.z), sigm(v.w)}; }
__device__ __forceinline__ f8 sigm8(f8 v) { f8 r; r.a = sigm4(v.a); r.b = sigm4(v.b); return r; }
__device__ __forceinline__ f32x4 exp4(f32x4 v) { return (f32x4){__expf(v.x), __expf(v.y), __expf(v.z), __expf(v.w)}; }
template <int CTRL> __device__ __forceinline__ float dpp_add(float x) { return x + __int_as_float(__builtin_amdgcn_update_dpp(0, __float_as_int(x), CTRL, 0xf, 0xf, true)); }
__device__ __forceinline__ float red8(float x) { x = dpp_add<0xB1>(x); x = dpp_add<0x4E>(x); x = dpp_add<0x141>(x); return x; }
__device__ __forceinline__ float red16(float x) { x = red8(x); x = dpp_add<0x140>(x); return x; }
__device__ __forceinline__ float wave_sum(float v) {
#pragma unroll
    for (int o = 1; o < 64; o <<= 1) v += __shfl_xor(v, o);
    return v;
}
__device__ __forceinline__ int cidx_of(int m) { return m < MP ? (m >> 11) : (NB + (m - MP)); }
__device__ __forceinline__ int prev_row(int m) { return m < MP ? (((m & (SEQ - 1)) > 0) ? m - 1 : -1) : m + DECB; }

struct EpiF32Bias {
    static constexpr bool PERM = false, AFTER_DRAIN = false;
    float* O; int ldc; const float* bias;
    __device__ __forceinline__ void operator()(const pg8::f32x4 (&acc)[2][2][4][2], const pg8::Unit& u, int wr, int wc, int fr, int fq) const {
        const int row0 = u.pm * 256 + wr * 64 + fr, col0 = u.pn * 256 + wc * 32 + 4 * fq;
#pragma unroll
        for (int ai = 0; ai < 2; ++ai)
#pragma unroll
            for (int m = 0; m < 4; ++m) { float* rowp = O + (size_t)(row0 + ai * 128 + m * 16) * ldc + col0;
#pragma unroll
                for (int bj = 0; bj < 2; ++bj)
#pragma unroll
                    for (int n = 0; n < 2; ++n) { const f32x4 bv = *(const f32x4*)(bias + col0 + bj * 128 + n * 16); *(f32x4*)(rowp + bj * 128 + n * 16) = acc[ai][bj][m][n] + bv; } }
    }
};
struct EpiGate {
    static constexpr bool PERM = true, AFTER_DRAIN = false;
    const bf16* gate; int ldg; bf16* out; int ldo; int accumulate;
    __device__ __forceinline__ void operator()(const pg8::f32x4 (&acc)[2][2][4][2], const pg8::Unit& u, int wr, int wc, int fr, int fq) const {
        const int row0 = u.pm * 256 + wr * 64 + fr, col0 = u.pn * 256 + wc * 32 + 8 * fq;
#pragma unroll
        for (int ai = 0; ai < 2; ++ai)
#pragma unroll
            for (int m = 0; m < 4; ++m) { const int row = row0 + ai * 128 + m * 16;
#pragma unroll
                for (int bj = 0; bj < 2; ++bj) { const int col = col0 + bj * 128;
                    f8 g = sigm8(ld8b(gate + (size_t)row * ldg + col)); f8 v; v.a = acc[ai][bj][m][0] * g.a; v.b = acc[ai][bj][m][1] * g.b;
                    bf16* op = out + (size_t)row * ldo + col;
                    if (accumulate) v = add8(v, ld8b(op));
                    *(u32x4*)op = pack8(v); }
                asm volatile("" ::: "memory"); }
    }
};
struct EpiRes {
    static constexpr bool PERM = false, AFTER_DRAIN = false;
    float* X; const float* mod;
    __device__ __forceinline__ void operator()(const pg8::f32x4 (&acc)[2][2][4][2], const pg8::Unit& u, int wr, int wc, int fr, int fq) const {
        const int row0 = u.pm * 256 + wr * 64 + fr, col0 = u.pn * 256 + wc * 32 + 4 * fq;
#pragma unroll
        for (int ai = 0; ai < 2; ++ai)
#pragma unroll
            for (int m = 0; m < 4; ++m) { const int row = row0 + ai * 128 + m * 16;
                if (row < MT) { float* xp = X + (size_t)row * D + col0; const float* gp = mod + (size_t)cidx_of(row) * NMOD2 + col0;
#pragma unroll
                    for (int bj = 0; bj < 2; ++bj)
#pragma unroll
                        for (int n = 0; n < 2; ++n) { const int o = bj * 128 + n * 16; const f32x4 g = *(const f32x4*)(gp + o); const f32x4 x = *(const f32x4*)(xp + o);
                            *(f32x4*)(xp + o) = x * ALPHA + (g + 1.0f) * acc[ai][bj][m][n]; } } }
    }
};

__device__ __forceinline__ void tr_item(const float* W, int ldw, bf16* WT, int ldk, int k0, int n0, const float* rowscale, LAS float* scr, int lane) {
#pragma unroll 8
    for (int i = 0; i < 32; ++i) { const int kk = 2 * i + (lane >> 5); scr[kk * 33 + (lane & 31)] = W[(size_t)(k0 + kk) * ldw + n0 + (lane & 31)]; }
    asm volatile("s_waitcnt lgkmcnt(0)" ::: "memory");
    const int c = lane & 7;
#pragma unroll
    for (int j = 0; j < 4; ++j) { const int n = (lane >> 3) + 8 * j; const LAS float* s = scr + (8 * c) * 33 + n; const float sc = rowscale ? rowscale[n0 + n] : 1.0f;
        u32x4 o; o.x = pk2(s[0 * 33] * sc, s[1 * 33] * sc); o.y = pk2(s[2 * 33] * sc, s[3 * 33] * sc); o.z = pk2(s[4 * 33] * sc, s[5 * 33] * sc); o.w = pk2(s[6 * 33] * sc, s[7 * 33] * sc);
        *(u32x4*)(WT + (size_t)(n0 + n) * ldk + k0 + 8 * c) = o; }
    asm volatile("s_waitcnt lgkmcnt(0)" ::: "memory");
}
__device__ __forceinline__ void phase_prep(KArgs ap, LAS unsigned char* lds, int tid, int lane, int wave, int bid, int G) {
    unsigned char* ws = ap->ws;
    LAS float* scr = (LAS float*)(lds + wave * 16384);
    const int gw = bid * NWAVES + wave, NGW = G * NWAVES;
    constexpr int PER_L = 2944 + 3072 + 32 + 32 + 64 + 512 + 32 + 256 + 512 + 2816 + 1408;
    for (int it = gw; it < NL * PER_L; it += NGW) {
        const int l = it / PER_L; int r = it % PER_L;
#define TR(NKB, NNB, Wp, ldw, WTp, ldk, rs) if (r < (NKB) * (NNB)) { const int kb = r / (NNB), nb = r % (NNB); tr_item((Wp), (ldw), (WTp), (ldk), kb * 64, nb * 32, (rs), scr, lane); continue; } r -= (NKB) * (NNB);
        TR(16, 184, ap->in[I_WIN] + (size_t)l * D * INC, INC, (bf16*)(ws + WS_WIN + l * SZ_WIN), D, nullptr)
        TR(16, 192, ap->in[I_ADAW] + (size_t)l * D * NMOD, NMOD, (bf16*)(ws + WS_ADA) + (size_t)l * NMOD * D, D, nullptr)
        TR(1, 32, ap->in[I_DUP] + (size_t)l * 64 * D, D, (bf16*)(ws + WS_LORA + l * SZ_LORA), 256, nullptr)
        TR(1, 32, ap->in[I_AUP] + (size_t)l * 64 * D, D, (bf16*)(ws + WS_LORA + l * SZ_LORA) + 1024 * 256 + 64, 256, nullptr)
        TR(2, 32, ap->in[I_GUP] + (size_t)l * 128 * D, D, (bf16*)(ws + WS_LORA + l * SZ_LORA) + 2048 * 256 + 128, 256, nullptr)
        TR(16, 32, ap->in[I_WBR] + (size_t)l * D * D, D, (bf16*)(ws + WS_WBR + l * SZ_WBR), D, nullptr)
        if (r < 32) { const int g = r >> 3, q = r & 7, kb = q >> 2, nb = q & 3;
            tr_item(ap->in[I_PW] + (size_t)(l * 4 + g) * 128 * 128, 128, (bf16*)(ws + WS_PW + l * SZ_PW) + (size_t)(g * 128) * 512 + g * 128, 512, kb * 64, nb * 32, ap->in[I_PS] + l * 512 + g * 128, scr, lane); continue; } r -= 32;
        TR(8, 32, ap->in[I_WBP] + (size_t)l * 512 * D, D, (bf16*)(ws + WS_WBP + l * SZ_WBP), 512, nullptr)
        TR(16, 32, ap->in[I_WOUT] + (size_t)l * D * D, D, (bf16*)(ws + WS_WOUT + l * SZ_WOUT), D, nullptr)
        TR(16, 176, ap->in[I_UP] + (size_t)l * D * FF2, FF2, (bf16*)(ws + WS_UP + l * SZ_UP), D, nullptr)
        TR(44, 32, ap->in[I_DOWN] + (size_t)l * DFF * D, D, (bf16*)(ws + WS_DOWN + l * SZ_DOWN), DFF, nullptr)
#undef TR
    }
    const int gt = bid * NTHR + tid, NGT = G * NTHR;
    const u32x4 z4 = (u32x4){0u, 0u, 0u, 0u};
    for (int i = gt; i < NL * 3072 * 32; i += NGT) { const int l = i / (3072 * 32), r = i % (3072 * 32), n = r >> 5, c = r & 31, blk = n >> 10;
        const bool diag = (blk == 0) ? (c < 8) : (blk == 1) ? (c >= 8 && c < 16) : (c >= 16);
        if (!diag) *(u32x4*)((bf16*)(ws + WS_LORA + l * SZ_LORA) + (size_t)n * 256 + c * 8) = z4; }
    for (int i = gt; i < NL * 512 * 64; i += NGT) { const int l = i / (512 * 64), r = i % (512 * 64), n = r >> 6, c = r & 63, g = n >> 7;
        if ((c >> 4) != g) *(u32x4*)((bf16*)(ws + WS_PW + l * SZ_PW) + (size_t)n * 512 + c * 8) = z4; }
    for (int i = gt; i < NL * 3072; i += NGT) { const int l = i / 3072, c = i % 3072;
        ((float*)(ws + WS_LBIAS))[i] = c < 1024 ? ap->in[I_DW0][l * D + c] : (c < 2048 ? ap->in[I_A0][l * D + c - 1024] : 0.f); }
    for (int i = gt; i < 256 * D / 2; i += NGT) { const int row = i / (D / 2), c = (i % (D / 2)) * 2; float v0 = 0.f, v1 = 0.f;
        if (row < NB) { v0 = ap->in[I_CP][row * D + c]; v1 = ap->in[I_CP][row * D + c + 1]; } else if (row < NB + DECB) { v0 = ap->in[I_CS][(row - NB) * D + c]; v1 = ap->in[I_CS][(row - NB) * D + c + 1]; }
        ((unsigned*)(ws + WS_CALL))[i] = pk2(v0, v1); }
}

__device__ __forceinline__ void phase_rowpass(KArgs ap, int stage, int l, int lane, int gw, int NGW) {
    unsigned char* ws = ap->ws; float* X = ap->out; bf16* H = (bf16*)(ws + WS_H); const float* MOD = (const float*)(ws + WS_MOD);
    for (int m = gw; m < MPAD; m += NGW) {
        if (m >= MT) {
            if (stage == 0 || stage == 2) { const float* src = ap->in[I_SSHIFT] + ((size_t)l * DECB + (m - MT)) * D;
#pragma unroll
                for (int j = 0; j < 4; ++j) { const f32x4 v = *(const f32x4*)(src + 4 * lane + 256 * j); u32x2 o; o.x = pk2(v.x, v.y); o.y = pk2(v.z, v.w); *(u32x2*)(H + (size_t)m * D + 4 * lane + 256 * j) = o; } }
            continue;
        }
        const float* src = (stage == 0) ? (m < MP ? ap->in[I_XP] + (size_t)m * D : ap->in[I_XS] + (size_t)(m - MP) * D) : X + (size_t)m * D;
        f32x4 v[4];
#pragma unroll
        for (int j = 0; j < 4; ++j) v[j] = *(const f32x4*)(src + 4 * lane + 256 * j);
        if (stage != 0) {
            const float* lw = (stage == 1) ? ap->in[I_LN1W] + l * D : ap->in[I_LN2W] + (l - 1) * D;
            const float* lb = (stage == 1) ? ap->in[I_LN1B] + l * D : ap->in[I_LN2B] + (l - 1) * D;
            float s = 0.f;
#pragma unroll
            for (int j = 0; j < 4; ++j) s += hsum4(v[j]);
            const float mean = wave_sum(s) * (1.f / D); float q = 0.f;
#pragma unroll
            for (int j = 0; j < 4; ++j) { v[j] = v[j] - mean; q += hsum4(v[j] * v[j]); }
            const float rstd = 1.0f / sqrtf(wave_sum(q) * (1.f / D) + LN_EPS);
#pragma unroll
            for (int j = 0; j < 4; ++j) v[j] = v[j] * rstd * *(const f32x4*)(lw + 4 * lane + 256 * j) + *(const f32x4*)(lb + 4 * lane + 256 * j);
        }
#pragma unroll
        for (int j = 0; j < 4; ++j) *(f32x4*)(X + (size_t)m * D + 4 * lane + 256 * j) = v[j];
        if (stage == 3) continue;
        float s = 0.f;
#pragma unroll
        for (int j = 0; j < 4; ++j) s += hsum4(v[j]);
        const float mean = wave_sum(s) * (1.f / D); float q = 0.f;
#pragma unroll
        for (int j = 0; j < 4; ++j) { v[j] = v[j] - mean; q += hsum4(v[j] * v[j]); }
        const float rstd = 1.0f / sqrtf(wave_sum(q) * (1.f / D) + LN_EPS);
        const float* sh = MOD + (size_t)cidx_of(m) * NMOD2 + l * NMOD + (stage == 1 ? 3 * D : 0); const float* sc = sh + D;
        float* so = nullptr;
        if (stage != 1) { if (m >= MP) so = ap->out + O_SHS + ((size_t)l * DECB + (m - MP)) * D; else if ((m & (SEQ - 1)) == SEQ - 1) so = ap->out + O_SHP + ((size_t)l * NB + (m >> 11)) * D; }
#pragma unroll
        for (int j = 0; j < 4; ++j) { const int c = 4 * lane + 256 * j; const f32x4 h = v[j] * rstd * (*(const f32x4*)(sc + c) + 1.0f) + *(const f32x4*)(sh + c);
            u32x2 o; o.x = pk2(h.x, h.y); o.y = pk2(h.z, h.w); *(u32x2*)(H + (size_t)m * D + c) = o;
            if (so) *(f32x4*)(so + c) = h; }
    }
}

__device__ __forceinline__ void phase_prepC(KArgs ap, int l, int gt, int NGT) {
    unsigned char* ws = ap->ws; const bf16* PROJ = (const bf16*)(ws + WS_PROJ); bf16* AL = (bf16*)(ws + WS_AL); bf16* PD = (bf16*)(ws + WS_PD);
    const float* mu = ap->in[I_MU] + (size_t)l * 3328 + C_WL; const float* spool = ap->in[I_SPOOL] + (size_t)l * DECB * PBUF * DPOOL;
    for (int idx = gt; idx < MT * 96; idx += NGT) {
        const int m = idx / 96, ch = idx % 96;
        if (ch < 32) {
            const int j0 = ch * 8; const f8 cur = ld8b(PROJ + (size_t)m * INC + C_WL + j0); const int pr = prev_row(m);
            const f8 prev = pr >= 0 ? ld8b(PROJ + (size_t)pr * INC + C_WL + j0) : zero8();
            f8 xs = mix8(cur, prev, ld8f(mu + j0));
            if (j0 < 64) { xs = sigm8(scl8(xs, 2.0f)); xs.a = xs.a * 2.0f - 1.0f; xs.b = xs.b * 2.0f - 1.0f; }
            else if (j0 >= 128) xs = sigm8(xs);
            *(u32x4*)(AL + (size_t)m * 256 + j0) = pack8(xs);
        } else {
            const int j0 = (ch - 32) * 8, g = j0 >> 7, win = 2 << g; const f8 cur = ld8b(PROJ + (size_t)m * INC + C_POOL + j0); f8 acc = cur; float cnt;
            if (m < MP) { const int t = m & (SEQ - 1); const int n = (t + 1 < win) ? t + 1 : win; cnt = (float)n;
                for (int i = 1; i < n; ++i) acc = add8(acc, ld8b(PROJ + (size_t)(m - i) * INC + C_POOL + j0)); }
            else { cnt = (float)win; const float* sp = spool + (size_t)(m - MP) * PBUF * DPOOL + j0;
                for (int i = 1; i < win; ++i) acc = add8(acc, ld8f(sp + (size_t)(PBUF - i) * DPOOL)); }
            const float ic = 1.0f / cnt; f8 d; d.a = acc.a * ic - cur.a; d.b = acc.b * ic - cur.b;
            *(u32x4*)(PD + (size_t)m * 512 + j0) = pack8(d);
        }
    }
    for (int idx = gt; idx < NB * PBUF * 64; idx += NGT) { const int c = idx & 63, i = (idx >> 6) % PBUF, b = idx / (64 * PBUF);
        const f8 v = ld8b(PROJ + (size_t)(b * SEQ + SEQ - PBUF + i) * INC + C_POOL + c * 8); float* o = ap->out + O_POOLP + (((size_t)l * NB + b) * PBUF + i) * DPOOL + c * 8;
        *(f32x4*)o = v.a; *(f32x4*)(o + 4) = v.b; }
    for (int idx = gt; idx < DECB * PBUF * 64; idx += NGT) { const int c = idx & 63, i = (idx >> 6) % PBUF, b = idx / (64 * PBUF);
        const f8 v = (i < PBUF - 1) ? ld8f(spool + ((size_t)b * PBUF + i + 1) * DPOOL + c * 8) : ld8b(PROJ + (size_t)(MP + b) * INC + C_POOL + c * 8);
        float* o = ap->out + O_POOLS + (((size_t)l * DECB + b) * PBUF + i) * DPOOL + c * 8; *(f32x4*)o = v.a; *(f32x4*)(o + 4) = v.b; }
}

struct ScanRaw { u32x4 cr, ck, cv, pr, pk, pv, dd, aa; };
__device__ __forceinline__ ScanRaw scan_load(const bf16* PROJ, const bf16* LO, int m, int cofs, bool has_prev) {
    ScanRaw r; const bf16* p = PROJ + (size_t)m * INC + cofs; const u32x4 z = (u32x4){0u, 0u, 0u, 0u};
    r.cr = *(const u32x4*)(p + C_R); r.ck = *(const u32x4*)(p + C_K); r.cv = *(const u32x4*)(p + C_V);
    if (has_prev) { const bf16* q = p - INC; r.pr = *(const u32x4*)(q + C_R); r.pk = *(const u32x4*)(q + C_K); r.pv = *(const u32x4*)(q + C_V); } else { r.pr = z; r.pk = z; r.pv = z; }
    const bf16* q = LO + (size_t)m * 3072 + cofs; r.dd = *(const u32x4*)q; r.aa = *(const u32x4*)(q + 1024);
    return r;
}
__device__ __forceinline__ void st8lds(LAS float* p, f8 v) { *(LAS f32x4*)p = v.a; *(LAS f32x4*)(p + 4) = v.b; }
__device__ __forceinline__ f8 ld8lds(const LAS float* p) { f8 r; r.a = *(const LAS f32x4*)p; r.b = *(const LAS f32x4*)(p + 4); return r; }
__device__ __forceinline__ void phase_scan(KArgs ap, int l, LAS unsigned char* lds, int tid, int lane, int wave, int bid, int G) {
    unsigned char* ws = ap->ws; const bf16* PROJ = (const bf16*)(ws + WS_PROJ); const bf16* LO = (const bf16*)(ws + WS_LO); bf16* Y = (bf16*)(ws + WS_Y); float* RK = (float*)(ws + WS_RK);
    LAS float* vec = (LAS float*)lds; LAS float* yb = (LAS float*)(lds + 98304); LAS float* cst = (LAS float*)(lds + 106496);
    const float* mu = ap->in[I_MU] + (size_t)l * 3328;
    for (int item = bid; item < NB * NH * 2; item += G) {
        const int bh = item >> 1, half = item & 1, b = bh >> 4, h = bh & 15;
        __syncthreads();
        if (tid < 64) { const int c = h * 64 + tid;
            cst[tid] = mu[C_R + c]; cst[64 + tid] = mu[C_K + c]; cst[128 + tid] = mu[C_V + c];
            cst[192 + tid] = ap->in[I_KK][l * D + c]; cst[256 + tid] = ap->in[I_KA][l * D + c]; cst[320 + tid] = ap->in[I_RK][l * D + c]; }
        const int tt = tid >> 3, jo = tid & 7, cofs = h * 64 + jo * 8;
        const int rowl = wave * 4 + (lane >> 4), kq = lane & 15, row = half * 32 + rowl;
        float s0 = 0.f, s1 = 0.f, s2 = 0.f, s3 = 0.f;
        const int mbase = b * SEQ;
        ScanRaw raw = scan_load(PROJ, LO, mbase + tt, cofs, tt > 0);
        for (int c = 0; c < SEQ / 64; ++c) {
            const int m0 = mbase + c * 64;
            __syncthreads();
            {
                const f8 r = mix8(unpack8(raw.cr), unpack8(raw.pr), ld8lds(cst + jo * 8));
                const f8 k = mix8(unpack8(raw.ck), unpack8(raw.pk), ld8lds(cst + 64 + jo * 8));
                const f8 v = mix8(unpack8(raw.cv), unpack8(raw.pv), ld8lds(cst + 128 + jo * 8));
                f8 w = sigm8(unpack8(raw.dd)); w.a = exp4(w.a * -0.60653065971f); w.b = exp4(w.b * -0.60653065971f);
                const f8 av = sigm8(unpack8(raw.aa));
                f8 kk = mul8(k, ld8lds(cst + 192 + jo * 8));
                const float ss = red8(hsum8(mul8(kk, kk))); const float inv = 1.0f / fmaxf(sqrtf(ss), 1e-12f); kk = scl8(kk, inv);
                const f8 ka = ld8lds(cst + 256 + jo * 8); f8 kp; kp.a = k.a * ((av.a - 1.0f) * ka.a + 1.0f); kp.b = k.b * ((av.b - 1.0f) * ka.b + 1.0f);
                const f8 bb = mul8(kk, av);
                const float rk = red8(hsum8(mul8(mul8(r, kp), ld8lds(cst + 320 + jo * 8))));
                LAS float* p = vec + tt * 384 + jo * 8;
                st8lds(p, kk); st8lds(p + 64, w); st8lds(p + 128, bb); st8lds(p + 192, kp); st8lds(p + 256, r); st8lds(p + 320, v);
                if (half == 0 && jo == 0) RK[(size_t)(m0 + tt) * 16 + h] = rk;
            }
            __syncthreads();
            if (c + 1 < SEQ / 64) raw = scan_load(PROJ, LO, m0 + 64 + tt, cofs, true);
#pragma unroll 4
            for (int t = 0; t < 64; ++t) {
                const LAS float* p = vec + t * 384 + 4 * kq;
                const f32x4 kk = *(const LAS f32x4*)p, w = *(const LAS f32x4*)(p + 64), bb = *(const LAS f32x4*)(p + 128), k4 = *(const LAS f32x4*)(p + 192), r4 = *(const LAS f32x4*)(p + 256);
                const float v = vec[t * 384 + 320 + row];
                float sa = (s0 * kk.x + s1 * kk.y) + (s2 * kk.z + s3 * kk.w); sa = red16(sa);
                s0 = s0 * w.x + (v * k4.x - sa * bb.x); s1 = s1 * w.y + (v * k4.y - sa * bb.y); s2 = s2 * w.z + (v * k4.z - sa * bb.z); s3 = s3 * w.w + (v * k4.w - sa * bb.w);
                float y = (s0 * r4.x + s1 * r4.y) + (s2 * r4.z + s3 * r4.w); y = red16(y);
                if (kq == 0) yb[t * 32 + rowl] = y;
            }
            __syncthreads();
            { const f32x4 yv = *(const LAS f32x4*)(yb + tt * 32 + jo * 4); u32x2 o; o.x = pk2(yv.x, yv.y); o.y = pk2(yv.z, yv.w);
              *(u32x2*)(Y + (size_t)(m0 + tt) * D + h * 64 + half * 32 + jo * 4) = o; }
        }
        *(f32x4*)(ap->out + O_WKVP + (((size_t)l * NB + b) * NH + h) * 4096 + row * 64 + 4 * kq) = (f32x4){s0, s1, s2, s3};
    }
    for (int it = bid; it < DECB * NH; it += G) {
        const int i = it >> 4, h = it & 15, m = MP + i;
        __syncthreads();
        if (wave == 0) { const int c = h * 64 + lane; const bf16* p = PROJ + (size_t)m * INC + c; const bf16* q = p + (size_t)DECB * INC;
            const float mr = mu[C_R + c], mk = mu[C_K + c], mv = mu[C_V + c];
            float r = bf1(p[C_R]), k = bf1(p[C_K]), v = bf1(p[C_V]); r += (bf1(q[C_R]) - r) * mr; k += (bf1(q[C_K]) - k) * mk; v += (bf1(q[C_V]) - v) * mv;
            const float w = __expf(-0.60653065971f * sigm(bf1(LO[(size_t)m * 3072 + c]))); const float av = sigm(bf1(LO[(size_t)m * 3072 + 1024 + c]));
            float kk = k * ap->in[I_KK][l * D + c]; const float ss = wave_sum(kk * kk); kk *= 1.0f / fmaxf(sqrtf(ss), 1e-12f);
            const float kp = k * (1.0f + (av - 1.0f) * ap->in[I_KA][l * D + c]); const float bb = kk * av;
            const float rk = wave_sum(r * kp * ap->in[I_RK][l * D + c]);
            vec[lane] = kk; vec[64 + lane] = w; vec[128 + lane] = bb; vec[192 + lane] = kp; vec[256 + lane] = r; vec[320 + lane] = v;
            if (lane == 0) RK[(size_t)m * 16 + h] = rk; }
        __syncthreads();
        const int row = tid >> 3, kq = tid & 7; const size_t so = (((size_t)l * DECB + i) * NH + h) * 4096 + row * 64 + kq * 8;
        f8 s = ld8f(ap->in[I_SWKV] + so);
        const f8 kk = ld8lds(vec + kq * 8), w = ld8lds(vec + 64 + kq * 8), bb = ld8lds(vec + 128 + kq * 8), k8 = ld8lds(vec + 192 + kq * 8), r8 = ld8lds(vec + 256 + kq * 8); const float v = vec[320 + row];
        const float sa = red8(hsum8(mul8(s, kk)));
        s.a = s.a * w.a + (k8.a * v - bb.a * sa); s.b = s.b * w.b + (k8.b * v - bb.b * sa);
        const float y = red8(hsum8(mul8(s, r8)));
        float* o = ap->out + O_WKVS + so; *(f32x4*)o = s.a; *(f32x4*)(o + 4) = s.b;
        if (kq == 0) Y[(size_t)m * D + h * 64 + row] = (bf16)(pk2(y, 0.f) & 0xffffu);
    }
}

__device__ __forceinline__ void phase_post(KArgs ap, int l, int gt, int NGT) {
    unsigned char* ws = ap->ws; const bf16* PROJ = (const bf16*)(ws + WS_PROJ); const bf16* LO = (const bf16*)(ws + WS_LO); bf16* Y = (bf16*)(ws + WS_Y); const float* RK = (const float*)(ws + WS_RK);
    const float* muv = ap->in[I_MU] + (size_t)l * 3328 + C_V; const float* gnw = ap->in[I_GNW] + l * D; const float* gnb = ap->in[I_GNB] + l * D;
    for (int idx = gt; idx < MT * 128; idx += NGT) {
        const int m = idx >> 7, c0 = (idx & 127) * 8, h = c0 >> 6;
        f8 y = ld8b(Y + (size_t)m * D + c0);
        const float mean = red8(hsum8(y)) * (1.0f / 64.0f); y.a = y.a - mean; y.b = y.b - mean;
        const float var = red8(hsum8(mul8(y, y))) * (1.0f / 64.0f); const float rstd = 1.0f / sqrtf(var + GN_EPS);
        const f8 cur = ld8b(PROJ + (size_t)m * INC + C_V + c0); const int pr = prev_row(m);
        const f8 prev = pr >= 0 ? ld8b(PROJ + (size_t)pr * INC + C_V + c0) : zero8();
        const f8 v = mix8(cur, prev, ld8f(muv + c0));
        const float rk = RK[(size_t)m * 16 + h]; const f8 g = ld8b(LO + (size_t)m * 3072 + 2048 + c0); const f8 gw = ld8f(gnw + c0), gb = ld8f(gnb + c0);
        f8 o; o.a = (y.a * rstd * gw.a + gb.a + v.a * rk) * g.a; o.b = (y.b * rstd * gw.b + gb.b + v.b * rk) * g.b;
        *(u32x4*)(Y + (size_t)m * D + c0) = pack8(o);
    }
}

__device__ __forceinline__ f8 conv8(f8 u0, f8 u1, f8 u2, const float* cw, const float* cb, int c) {
    const f8 w0 = ld8f(cw + c), w1 = ld8f(cw + FF2 + c), w2 = ld8f(cw + 2 * FF2 + c), bb = ld8f(cb + c); f8 r;
    r.a = bb.a + u0.a * w0.a + u1.a * w1.a + u2.a * w2.a; r.b = bb.b + u0.b * w0.b + u1.b * w1.b + u2.b * w2.b; return r;
}
__device__ __forceinline__ void phase_conv(KArgs ap, int l, int gt, int NGT) {
    unsigned char* ws = ap->ws; const bf16* U = (const bf16*)(ws + WS_U); bf16* ACT = (bf16*)(ws + WS_ACT);
    const float* cw = ap->in[I_CW] + (size_t)l * 3 * FF2; const float* cb = ap->in[I_CB] + (size_t)l * FF2; const float* sconv = ap->in[I_SCONV] + (size_t)l * DECB * 2 * FF2;
    for (int idx = gt; idx < MT * 352; idx += NGT) {
        const int m = idx / 352, f0 = (idx % 352) * 8;
        const bf16* up = U + (size_t)m * FF2 + f0;
        const f8 v2 = ld8b(up), g2 = ld8b(up + DFF); f8 v1, g1, v0, g0;
        if (m < MP) { const int t = m & (SEQ - 1);
            if (t >= 1) { v1 = ld8b(up - FF2); g1 = ld8b(up - FF2 + DFF); } else { v1 = zero8(); g1 = zero8(); }
            if (t >= 2) { v0 = ld8b(up - 2 * FF2); g0 = ld8b(up - 2 * FF2 + DFF); } else { v0 = zero8(); g0 = zero8(); } }
        else { const float* sp = sconv + (size_t)(m - MP) * 2 * FF2 + f0; v0 = ld8f(sp); g0 = ld8f(sp + DFF); v1 = ld8f(sp + FF2); g1 = ld8f(sp + FF2 + DFF); }
        const f8 val = conv8(v0, v1, v2, cw, cb, f0), gate = conv8(g0, g1, g2, cw, cb, f0 + DFF);
        const f8 sg = sigm8(gate); f8 o; o.a = val.a * gate.a * sg.a; o.b = val.b * gate.b * sg.b;
        *(u32x4*)(ACT + (size_t)m * DFF + f0) = pack8(o);
    }
    for (int idx = gt; idx < NB * 2 * 704; idx += NGT) { const int c = (idx % 704) * 8, i = (idx / 704) & 1, b = idx / 1408;
        const f8 v = ld8b(U + (size_t)(b * SEQ + SEQ - 2 + i) * FF2 + c); float* o = ap->out + O_CONVP + (((size_t)l * NB + b) * 2 + i) * FF2 + c; *(f32x4*)o = v.a; *(f32x4*)(o + 4) = v.b; }
    for (int idx = gt; idx < DECB * 2 * 704; idx += NGT) { const int c = (idx % 704) * 8, i = (idx / 704) & 1, b = idx / 1408;
        const f8 v = (i == 0) ? ld8f(sconv + ((size_t)b * 2 + 1) * FF2 + c) : ld8b(U + (size_t)(MP + b) * FF2 + c);
        float* o = ap->out + O_CONVS + (((size_t)l * DECB + b) * 2 + i) * FF2 + c; *(f32x4*)o = v.a; *(f32x4*)(o + 4) = v.b; }
}

#ifndef MK_MULTI
#define MK_MULTI 1
#endif
constexpr int PH_PER_LAYER = 12, N_PHASES = 2 + NL * PH_PER_LAYER + 1;

template <class Epi> __device__ __forceinline__ void run_gemm(LAS unsigned char* lds, const bf16* A, const bf16* Bt, int N, int K, int G, int bid, const Epi& E) {
    pg8::Gemm g{A, Bt, MPAD, N, K}; pg8::StaticOrder S; S.init(MPAD, N, G, bid);
    pg8::gemm_phase<Epi, pg8::StaticOrder, true, true>((PG8_LAS unsigned char*)lds, g, S, E);
}

__global__ void __launch_bounds__(NTHR, 2) mega_fwd(Args a_unused) {
    extern __shared__ __attribute__((aligned(16))) unsigned char lds_raw[];
    LAS unsigned char* lds = (LAS unsigned char*)lds_raw;
    const int bid = blockIdx.x, G = gridDim.x;
#define TIDS const int tid = opqv((int)threadIdx.x), lane = tid & 63, wave = __builtin_amdgcn_readfirstlane(tid >> 6); (void)lane; (void)wave;
    int lo, hi; { KArgs ap0 = fresh_args(); lo = ap0->ph_lo; hi = ap0->ph_hi; }
#ifndef EN_MASK
#define EN_MASK 0xffffffffu
#endif
#define EN(x) ((EN_MASK >> (x)) & 1u)
#define IN(k) (lo <= (k) && (k) < hi)
#define SEAM(k) do { if (IN(k) && IN((k) + 1)) { cg::this_grid().sync(); } } while (0)
#define WSP(T, off) ((T*)(ws + (off)))
    if (EN(0) && IN(0)) { TIDS phase_prep(fresh_args(), lds, tid, lane, wave, opq(bid), opq(G)); }
    SEAM(0);
    if (EN(1) && IN(1)) { KArgs ap = fresh_args(); unsigned char* ws = ap->ws; EpiF32Bias E{WSP(float, WS_MOD), NMOD2, ap->in[I_ADAB]};
        pg8::Gemm g{WSP(const bf16, WS_CALL), WSP(const bf16, WS_ADA), 256, NMOD2, D}; pg8::StaticOrder S; S.init(256, NMOD2, opq(G), opq(bid));
        pg8::gemm_phase<EpiF32Bias, pg8::StaticOrder, true, true>((PG8_LAS unsigned char*)lds, g, S, E); }
    SEAM(1);
#pragma nounroll
    for (int l = 0; l < NL; ++l) {
        const int P = 2 + l * PH_PER_LAYER;
        if (EN(2) && IN(P + 0)) { TIDS phase_rowpass(fresh_args(), l == 0 ? 0 : 2, l, lane, opq(bid) * NWAVES + wave, opq(G) * NWAVES); }
        SEAM(P + 0);
        if (EN(3) && IN(P + 1)) { KArgs ap = fresh_args(); unsigned char* ws = ap->ws;
            pg8::EpiBf16<0> E{WSP(bf16, WS_PROJ), INC, nullptr, 0, 0, 1.f}; run_gemm(lds, WSP(const bf16, WS_H), WSP(const bf16, WS_WIN + l * SZ_WIN), INC, D, opq(G), opq(bid), E); }
        SEAM(P + 1);
        if (EN(4) && IN(P + 2)) { TIDS phase_prepC(fresh_args(), l, opq(bid) * NTHR + tid, opq(G) * NTHR); }
        SEAM(P + 2);
        if (EN(5) && IN(P + 3)) {
            { KArgs ap = fresh_args(); unsigned char* ws = ap->ws; pg8::EpiBf16<0> E{WSP(bf16, WS_LO), 3072, WSP(const float, WS_LBIAS) + l * 3072, 0, 0, 1.f};
              run_gemm(lds, WSP(const bf16, WS_AL), WSP(const bf16, WS_LORA + l * SZ_LORA), 3072, 256, opq(G), opq(bid), E); }
            { KArgs ap = fresh_args(); unsigned char* ws = ap->ws; pg8::EpiBf16<0> E{WSP(bf16, WS_PM), 512, nullptr, 0, 0, 1.f};
              run_gemm(lds, WSP(const bf16, WS_PD), WSP(const bf16, WS_PW + l * SZ_PW), 512, 512, opq(G), opq(bid), E); } }
        SEAM(P + 3);
        if (EN(6) && IN(P + 4)) { TIDS phase_scan(fresh_args(), l, lds, tid, lane, wave, opq(bid), opq(G)); }
        SEAM(P + 4);
        if (EN(7) && IN(P + 5)) { TIDS phase_post(fresh_args(), l, opq(bid) * NTHR + tid, opq(G) * NTHR); }
        SEAM(P + 5);
        if (EN(8) && IN(P + 6)) {
            { KArgs ap = fresh_args(); unsigned char* ws = ap->ws; EpiGate E{WSP(const bf16, WS_PROJ) + C_GP, INC, WSP(bf16, WS_MG), D, 0};
              run_gemm(lds, WSP(const bf16, WS_PM), WSP(const bf16, WS_WBP + l * SZ_WBP), D, 512, opq(G), opq(bid), E); }
            { KArgs ap = fresh_args(); unsigned char* ws = ap->ws; EpiGate E{WSP(const bf16, WS_PROJ) + C_GR, INC, WSP(bf16, WS_MG), D, 1};
              run_gemm(lds, WSP(const bf16, WS_Y), WSP(const bf16, WS_WBR + l * SZ_WBR), D, D, opq(G), opq(bid), E); } }
        SEAM(P + 6);
        if (EN(9) && IN(P + 7)) { KArgs ap = fresh_args(); unsigned char* ws = ap->ws; EpiRes E{ap->out, WSP(const float, WS_MOD) + l * NMOD + 2 * D};
            run_gemm(lds, WSP(const bf16, WS_MG), WSP(const bf16, WS_WOUT + l * SZ_WOUT), D, D, opq(G), opq(bid), E); }
        SEAM(P + 7);
        if (EN(10) && IN(P + 8)) { TIDS phase_rowpass(fresh_args(), 1, l, lane, opq(bid) * NWAVES + wave, opq(G) * NWAVES); }
        SEAM(P + 8);
        if (EN(11) && IN(P + 9)) { KArgs ap = fresh_args(); unsigned char* ws = ap->ws; pg8::EpiBf16<0> E{WSP(bf16, WS_U), FF2, nullptr, 0, 0, 1.f};
            run_gemm(lds, WSP(const bf16, WS_H), WSP(const bf16, WS_UP + l * SZ_UP), FF2, D, opq(G), opq(bid), E); }
        SEAM(P + 9);
        if (EN(12) && IN(P + 10)) { TIDS phase_conv(fresh_args(), l, opq(bid) * NTHR + tid, opq(G) * NTHR); }
        SEAM(P + 10);
        if (EN(13) && IN(P + 11)) { KArgs ap = fresh_args(); unsigned char* ws = ap->ws; EpiRes E{ap->out, WSP(const float, WS_MOD) + l * NMOD + 5 * D};
            run_gemm(lds, WSP(const bf16, WS_ACT), WSP(const bf16, WS_DOWN + l * SZ_DOWN), D, DFF, opq(G), opq(bid), E); }
        SEAM(P + 11);
    }
    if (EN(14) && IN(N_PHASES - 1)) { TIDS phase_rowpass(fresh_args(), 3, NL, lane, opq(bid) * NWAVES + wave, opq(G) * NWAVES); }
#undef IN
#undef SEAM
}

extern "C" void kernel_launch(void* const* d_in, const int* in_sizes, int n_in, void* d_out, int out_size, void* d_ws, size_t ws_size, hipStream_t stream) {
    static int grid = 0;
    if (grid == 0) {
        if (n_in != N_IN || (size_t)out_size != O_END || ws_size < WS_END) { fprintf(stderr, "kernel_launch: unexpected shapes (n_in %d out %d ws %zu)\n", n_in, out_size, ws_size); grid = -1; return; }
        int dev = 0, cus = 0, per_cu = 0;
        if (hipGetDevice(&dev) != hipSuccess || hipDeviceGetAttribute(&cus, hipDeviceAttributeMultiprocessorCount, dev) != hipSuccess) { grid = -1; return; }
        if (hipFuncSetAttribute((const void*)mega_fwd, hipFuncAttributeMaxDynamicSharedMemorySize, LDS_BYTES) != hipSuccess) { fprintf(stderr, "kernel_launch: hipFuncSetAttribute failed\n"); grid = -1; return; }
        if (hipOccupancyMaxActiveBlocksPerMultiprocessor(&per_cu, (const void*)mega_fwd, NTHR, LDS_BYTES) != hipSuccess || per_cu < 1) { fprintf(stderr, "kernel_launch: occupancy query says %d\n", per_cu); per_cu = 1; }
        (void)hipGetLastError();
        grid = cus * 1;
    }
    if (grid < 0) return;
    Args a{};
    for (int i = 0; i < N_IN; ++i) a.in[i] = (const float*)d_in[i];
    a.out = (float*)d_out; a.ws = (unsigned char*)d_ws;
#if MK_MULTI
    for (int p = 0; p < N_PHASES; ++p) { a.ph_lo = p; a.ph_hi = p + 1; hipLaunchKernelGGL(mega_fwd, dim3(grid), dim3(NTHR), LDS_BYTES, stream, a); }
#else
    a.ph_lo = 0; a.ph_hi = N_PHASES;
    void* args[] = {&a};
    hipError_t e = hipLaunchCooperativeKernel((const void*)mega_fwd, dim3(grid), dim3(NTHR), args, LDS_BYTES, stream);
    if (e != hipSuccess) fprintf(stderr, "kernel_launch: cooperative launch failed: %s (grid %d)\n", hipGetErrorString(e), grid);
#endif
}
```

```cpp
#include <hip/hip_runtime.h>
#include <hip/hip_cooperative_groups.h>
#include <cstdio>
#include <cstdint>
namespace cg = cooperative_groups;
namespace pg8 {
#define PG8_LAS __attribute__((address_space(3)))
typedef unsigned short bf16_t;
typedef short bf16x8 __attribute__((ext_vector_type(8)));
typedef float f32x4 __attribute__((ext_vector_type(4)));
typedef unsigned u32x4 __attribute__((ext_vector_type(4)));
constexpr int BM = 256, BK = 64, HALF = 128, HTB = HALF * BK * 2  , STAGE_BYTES = 8 * HTB, NXCD = 8, WGM = 8;

__host__ __device__ __forceinline__ int lds_byte(int r, int c) { const int st = (r >> 4) * 2 + (c >> 5), rr = r & 15, cc = c & 31, ob = rr * 64 + cc * 2; return st * 1024 + (ob ^ (((ob >> 9) & 1) << 5)); }
__host__ __device__ __forceinline__ void stage_rc(int b, int& R, int& C) { const int st = b / 1024, sb = b % 1024, swz = sb ^ (((sb >> 9) & 1) << 5); R = (st >> 1) * 16 + swz / 64; C = (st & 1) * 32 + (swz % 64) / 2; }
__host__ __device__ __forceinline__ int perm32(int rho) { const int n = rho >> 4, i = rho & 15; return 8 * (i >> 2) + 4 * n + (i & 3); }

struct Unit { int pm, pn; };
struct Gemm { const bf16_t* A; const bf16_t* Bt; int M, N, K; };

struct StaticOrder {
    int nM, nN, nwg, G, c;
    __host__ __device__ void init(int M, int N, int G_, int c_) { nM = M / BM; nN = N / BM; nwg = nM * nN; G = G_; c = c_; }
    __host__ __device__ bool next(int i, Unit& u) const {
        const long L = (long)i * G + c; if (L >= nwg) return false;
        int wgid = (int)L; { const int q = nwg / NXCD, r = nwg % NXCD, xcd = wgid % NXCD, off = wgid / NXCD; wgid = (xcd < r ? xcd * (q + 1) : r * (q + 1) + (xcd - r) * q) + off; }
        const int nig = WGM * nN, gid = wgid / nig, fm = gid * WGM, gsz = (nM - fm) < WGM ? (nM - fm) : WGM;
        u.pm = fm + ((wgid % nig) % gsz); u.pn = (wgid % nig) / gsz; return true;
    }
    __device__ __forceinline__ void a_ready(const Unit&) const {}
    __device__ __forceinline__ void done(const Unit&) const {}
};

__device__ __forceinline__ unsigned cvt_pk_bf16(float lo, float hi) { unsigned r; asm volatile("v_cvt_pk_bf16_f32 %0, %1, %2" : "=v"(r) : "v"(lo), "v"(hi)); return r; }
typedef float f32x2 __attribute__((ext_vector_type(2)));
__device__ __forceinline__ f32x2 gelu_pk(f32x2 v) {
    const f32x2 av = __builtin_elementwise_abs(v), d = av * 0.2316418882f + 1.0f;
    f32x2 t; t.x = __builtin_amdgcn_rcpf(d.x); t.y = __builtin_amdgcn_rcpf(d.y);
    f32x2 q = t * 0.5307027145f + (-0.7265760135f); q = q * t + 0.7107068705f; q = q * t + (-0.142248368f); q = q * t + 0.127414796f; q = q * t;
    const f32x2 s = (v * v) * (-0.72134752044f);
    f32x2 e; e.x = __builtin_amdgcn_exp2f(s.x); e.y = __builtin_amdgcn_exp2f(s.y);
    const f32x2 m = v * (q * e), r = v - m;
    f32x2 o; o.x = v.x < 0.f ? m.x : r.x; o.y = v.y < 0.f ? m.y : r.y; return o;
}

template <int ACT  > struct EpiBf16 {
    static constexpr bool PERM = true, AFTER_DRAIN = false; static_assert(ACT == 0 || ACT == 1, "EpiBf16: ACT is 0 (none) or 1 (gelu_pk)");
    bf16_t* O; int ldc; const float* bias; int split_cols; size_t split_stride; float scale0;
    __device__ __forceinline__ void operator()(const f32x4 (&acc)[2][2][4][2], const Unit& u, int wr, int wc, int fr, int fq) const {
        const int row0 = u.pm * BM + wr * 64 + fr; int colt = u.pn * BM; bf16_t* base = O;
        float sc = 1.f; if (split_cols) { const int t = colt / split_cols; base += (size_t)t * split_stride; colt -= t * split_cols; if (t == 0) sc = scale0; }
        const int col0 = colt + wc * 32 + 8 * fq, bcol0 = u.pn * BM + wc * 32 + 8 * fq;
        f32x4 bv[2][2];
#pragma unroll
        for (int bj = 0; bj < 2; ++bj)
#pragma unroll
            for (int n = 0; n < 2; ++n) bv[bj][n] = bias ? *(const f32x4*)(bias + bcol0 + bj * HALF + 4 * n) : (f32x4){0.f, 0.f, 0.f, 0.f};
#pragma unroll
        for (int ai = 0; ai < 2; ++ai)
#pragma unroll
            for (int m = 0; m < 4; ++m) { bf16_t* rowp = base + (size_t)(row0 + ai * HALF + m * 16) * ldc + col0;
#pragma unroll
                for (int bj = 0; bj < 2; ++bj) { f32x4 v0 = acc[ai][bj][m][0] + bv[bj][0], v1 = acc[ai][bj][m][1] + bv[bj][1];
                    if (ACT == 1) { f32x2 a = gelu_pk((f32x2){v0[0], v0[1]}), b = gelu_pk((f32x2){v0[2], v0[3]}), c = gelu_pk((f32x2){v1[0], v1[1]}), d = gelu_pk((f32x2){v1[2], v1[3]});
                        v0 = (f32x4){a.x, a.y, b.x, b.y}; v1 = (f32x4){c.x, c.y, d.x, d.y}; }
                    v0 = v0 * sc; v1 = v1 * sc; u32x4 w; w.x = cvt_pk_bf16(v0[0], v0[1]); w.y = cvt_pk_bf16(v0[2], v0[3]); w.z = cvt_pk_bf16(v1[0], v1[1]); w.w = cvt_pk_bf16(v1[2], v1[3]);
                    *(u32x4*)(rowp + bj * HALF) = w; } }
    }
};

struct PanelStats {
    unsigned* xbuf;
    unsigned* cnt;
    unsigned* tmo;
    int ntn; float eps;
    unsigned code;
    __device__ __forceinline__ bool run(const f32x4 (&v)[2][2][4][2], const Unit& u, int wr, int wc, int fr, int fq, PG8_LAS unsigned char* lds, int wid, int lane) const {
        typedef float f32x2v __attribute__((ext_vector_type(2)));
        PG8_LAS f32x2v* P = (PG8_LAS f32x2v*)lds;
        PG8_LAS f32x2v* S = (PG8_LAS f32x2v*)(lds + 8192);
        PG8_LAS unsigned* flag = (PG8_LAS unsigned*)(lds + 8192 + 2048);
#pragma unroll
        for (int ai = 0; ai < 2; ++ai)
#pragma unroll
            for (int m = 0; m < 4; ++m) {
                float s = 0.f;
#pragma unroll
                for (int bj = 0; bj < 2; ++bj)
#pragma unroll
                    for (int n = 0; n < 2; ++n) { const f32x4 x = v[ai][bj][m][n]; s += (x[0] + x[1]) + (x[2] + x[3]); }
                s += __shfl_xor(s, 16); s += __shfl_xor(s, 32);
                const float mw = s * (1.0f / 64.0f); float q = 0.f;
#pragma unroll
                for (int bj = 0; bj < 2; ++bj)
#pragma unroll
                    for (int n = 0; n < 2; ++n) { const f32x4 d = v[ai][bj][m][n] - mw; q += (d[0] * d[0] + d[1] * d[1]) + (d[2] * d[2] + d[3] * d[3]); }
                q += __shfl_xor(q, 16); q += __shfl_xor(q, 32);
                if (fq == 0) P[(ai * HALF + wr * 64 + m * 16 + fr) * 4 + wc] = (f32x2v){mw, q};
            }
        asm volatile("s_waitcnt lgkmcnt(0)" ::: "memory"); __builtin_amdgcn_s_barrier(); asm volatile("" ::: "memory");
#if defined(BROKEN_EXCHANGE_NO_WAIT)
#warning BROKEN CONTROL BUILD: the row-statistics exchange does not wait; results are wrong by design
        if (blockIdx.x >= 64) { const long long t0_ = clock64(); while (clock64() - t0_ < 60000) __builtin_amdgcn_s_sleep(8); }
#endif
        const int row = wid * 32 + (lane & 31);
        if (lane < 32) {
            const f32x2v a = P[row * 4 + 0], b = P[row * 4 + 1], c = P[row * 4 + 2], d = P[row * 4 + 3];
            const float mt = (a.x + b.x + c.x + d.x) * 0.25f;
            const float da = a.x - mt, db = b.x - mt, dc = c.x - mt, dd = d.x - mt;
            const float m2 = (a.y + b.y) + (c.y + d.y) + 64.0f * ((da * da + db * db) + (dc * dc + dd * dd));
            unsigned long long* slot = (unsigned long long*)xbuf + ((size_t)(u.pm * BM + row) * 4 + u.pn);
            __hip_atomic_store(slot, ((unsigned long long)__float_as_uint(m2) << 32) | __float_as_uint(mt), __ATOMIC_RELAXED, __HIP_MEMORY_SCOPE_AGENT);
        }
        asm volatile("s_waitcnt vmcnt(0)" ::: "memory");
        if (lane == 0) __hip_atomic_fetch_add(cnt + 64 * u.pm, 1u, __ATOMIC_RELAXED, __HIP_MEMORY_SCOPE_AGENT);
        if (wid == 0) {
            bool dead = false; const unsigned long long t0 = __builtin_amdgcn_s_memrealtime(); const unsigned want = 8u * (unsigned)ntn;
            for (;;) {
#if defined(BROKEN_EXCHANGE_NO_WAIT)
                break;
#endif
                if ((unsigned)__builtin_amdgcn_readfirstlane(__hip_atomic_load(cnt + 64 * u.pm, __ATOMIC_RELAXED, __HIP_MEMORY_SCOPE_AGENT)) >= want) break;
                if (__builtin_amdgcn_s_memrealtime() - t0 > 2000000ull) {
                    if (lane == 0) { unsigned expect = 0u; __hip_atomic_compare_exchange_strong(tmo + 1, &expect, code | (unsigned)(u.pm & 0xff), __ATOMIC_RELAXED, __ATOMIC_RELAXED, __HIP_MEMORY_SCOPE_AGENT);
                                     __hip_atomic_store(tmo, 1u, __ATOMIC_RELAXED, __HIP_MEMORY_SCOPE_AGENT); }
                    dead = true; break; }
                __builtin_amdgcn_s_sleep(2);
            }
            __builtin_amdgcn_fence(__ATOMIC_ACQUIRE, "agent");
            if (lane == 0) flag[0] = dead ? 1u : 0u;
        }
        asm volatile("s_waitcnt vmcnt(0) lgkmcnt(0)" ::: "memory"); __builtin_amdgcn_s_barrier(); asm volatile("" ::: "memory");
        const bool bad = flag[0] != 0u;
        if (lane < 32) {
            const unsigned long long* slot = (const unsigned long long*)xbuf + (size_t)(u.pm * BM + row) * 4; float mt[4], m2[4]; float ms = 0.f;
#pragma unroll
            for (int t = 0; t < 4; ++t) { if (t < ntn) { const unsigned long long w = __hip_atomic_load(slot + t, __ATOMIC_RELAXED, __HIP_MEMORY_SCOPE_AGENT); mt[t] = __uint_as_float((unsigned)w); m2[t] = __uint_as_float((unsigned)(w >> 32)); } else { mt[t] = 0.f; m2[t] = 0.f; } ms += mt[t]; }
            const float mean = ms / (float)ntn; float q = 0.f;
#pragma unroll
            for (int t = 0; t < 4; ++t) if (t < ntn) { const float dm = mt[t] - mean; q += m2[t] + 256.0f * dm * dm; }
            S[row] = (f32x2v){mean, 1.0f / sqrtf(q / (256.0f * (float)ntn) + eps)};
        }
        asm volatile("s_waitcnt lgkmcnt(0)" ::: "memory"); __builtin_amdgcn_s_barrier(); asm volatile("" ::: "memory");
        return bad;
    }
};
struct EpiLnRes {
    static constexpr bool PERM = false, AFTER_DRAIN = true;
    const float* base; float* out; int ldc; const float* bias; PanelStats st; unsigned poison;
    __device__ __forceinline__ void fused(f32x4 (&acc)[2][2][4][2], const Unit& u, int wr, int wc, int fr, int fq, PG8_LAS unsigned char* lds, int wid, int lane) const {
        typedef float f32x2v __attribute__((ext_vector_type(2)));
        const PG8_LAS f32x2v* S = (const PG8_LAS f32x2v*)(lds + 8192);
        const int col0 = u.pn * BM + wc * 32 + 4 * fq;
#pragma unroll
        for (int bj = 0; bj < 2; ++bj)
#pragma unroll
            for (int n = 0; n < 2; ++n) { const f32x4 bv = bias ? *(const f32x4*)(bias + col0 + bj * HALF + n * 16) : (f32x4){0.f, 0.f, 0.f, 0.f};
#pragma unroll
                for (int ai = 0; ai < 2; ++ai)
#pragma unroll
                    for (int m = 0; m < 4; ++m) acc[ai][bj][m][n] += bv; }
        f32x4 pre[4][2][2];
#pragma unroll
        for (int m = 0; m < 4; ++m) { const size_t off = (size_t)(u.pm * BM + wr * 64 + m * 16 + fr) * ldc + col0;
#pragma unroll
            for (int bj = 0; bj < 2; ++bj)
#pragma unroll
                for (int n = 0; n < 2; ++n) pre[m][bj][n] = *(const f32x4*)(base + off + bj * HALF + n * 16); }
        const bool bad = st.run(acc, u, wr, wc, fr, fq, lds, wid, lane) || poison != 0u;
        const float qnan = __builtin_nanf("");
#pragma unroll
        for (int ai = 0; ai < 2; ++ai)
#pragma unroll
            for (int m = 0; m < 4; ++m) { const int r = ai * HALF + wr * 64 + m * 16 + fr; const f32x2v sr = S[r]; const size_t off = (size_t)(u.pm * BM + r) * ldc + col0;
#pragma unroll
                for (int bj = 0; bj < 2; ++bj)
#pragma unroll
                    for (int n = 0; n < 2; ++n) { const f32x4 bs = ai == 0 ? pre[m][bj][n] : *(const f32x4*)(base + off + bj * HALF + n * 16); f32x4 o = bs + (acc[ai][bj][m][n] - sr.x) * sr.y;
                        if (bad) o = (f32x4){qnan, qnan, qnan, qnan}; *(f32x4*)(out + off + bj * HALF + n * 16) = o; }
                if (m & 1) asm volatile("" ::: "memory"); }
    }
};
struct EpiLnResLn {
    static constexpr bool PERM = false, AFTER_DRAIN = true;
    const float* base; float* out; bf16_t* xn; int ldc; const float* bias; PanelStats st1, st2; unsigned poison;
    __device__ __forceinline__ void fused(f32x4 (&acc)[2][2][4][2], const Unit& u, int wr, int wc, int fr, int fq, PG8_LAS unsigned char* lds, int wid, int lane) const {
        typedef float f32x2v __attribute__((ext_vector_type(2))); typedef unsigned u32x2v __attribute__((ext_vector_type(2)));
        const PG8_LAS f32x2v* S = (const PG8_LAS f32x2v*)(lds + 8192);
        const int col0 = u.pn * BM + wc * 32 + 4 * fq;
#pragma unroll
        for (int bj = 0; bj < 2; ++bj)
#pragma unroll
            for (int n = 0; n < 2; ++n) { const f32x4 bv = bias ? *(const f32x4*)(bias + col0 + bj * HALF + n * 16) : (f32x4){0.f, 0.f, 0.f, 0.f};
#pragma unroll
                for (int ai = 0; ai < 2; ++ai)
#pragma unroll
                    for (int m = 0; m < 4; ++m) acc[ai][bj][m][n] += bv; }
        bool bad = st1.run(acc, u, wr, wc, fr, fq, lds, wid, lane) || poison != 0u;
        const float qnan = __builtin_nanf("");
#pragma unroll
        for (int ai = 0; ai < 2; ++ai)
#pragma unroll
            for (int m = 0; m < 4; ++m) { const int r = ai * HALF + wr * 64 + m * 16 + fr; const f32x2v sr = S[r]; const size_t off = (size_t)(u.pm * BM + r) * ldc + col0;
#pragma unroll
                for (int bj = 0; bj < 2; ++bj)
#pragma unroll
                    for (int n = 0; n < 2; ++n) { const f32x4 bs = *(const f32x4*)(base + off + bj * HALF + n * 16); acc[ai][bj][m][n] = bs + (acc[ai][bj][m][n] - sr.x) * sr.y; }
                asm volatile("" : "+v"(acc[ai][0][m][0]), "+v"(acc[ai][0][m][1]), "+v"(acc[ai][1][m][0]), "+v"(acc[ai][1][m][1]));
                if (m & 1) asm volatile("" ::: "memory"); }
        const bool bad1 = bad;
        bad = st2.run(acc, u, wr, wc, fr, fq, lds, wid, lane) || bad;
#pragma unroll
        for (int ai = 0; ai < 2; ++ai)
#pragma unroll
            for (int m = 0; m < 4; ++m) { const int r = ai * HALF + wr * 64 + m * 16 + fr; const f32x2v sr = S[r]; const size_t off = (size_t)(u.pm * BM + r) * ldc + col0;
#pragma unroll
                for (int bj = 0; bj < 2; ++bj)
#pragma unroll
                    for (int n = 0; n < 2; ++n) { const f32x4 x1 = acc[ai][bj][m][n]; *(f32x4*)(out + off + bj * HALF + n * 16) = bad1 ? (f32x4){qnan, qnan, qnan, qnan} : x1;
                        const f32x4 o = (x1 - sr.x) * sr.y; u32x2v w; w.x = cvt_pk_bf16(o[0], o[1]); w.y = cvt_pk_bf16(o[2], o[3]);
                        if (bad) { w.x = 0x7fc07fc0u; w.y = 0x7fc07fc0u; } *(u32x2v*)(xn + off + bj * HALF + n * 16) = w; }
                asm volatile("" ::: "memory"); }
    }
};

template <class Epi, class Sched, bool ALIGN_EPI = false, bool SP2 = false>
__device__ __forceinline__ void gemm_phase(PG8_LAS unsigned char* lds, const Gemm g, const Sched& S, const Epi& E) {
    int tid_ = threadIdx.x; asm volatile("" : "+v"(tid_));
    const int tid = tid_, wid = __builtin_amdgcn_readfirstlane(tid >> 6), lane = tid & 63, wr = wid >> 2, wc = wid & 3, fr = lane & 15, fq = lane >> 4;
    const int K = g.K, nt = K / BK;
    unsigned voffA[2], voffB[2];
#pragma unroll
    for (int i = 0; i < 2; ++i) { int R, C; stage_rc(tid * 16 + i * 8192, R, C); const int Rb = Epi::PERM ? ((R & ~31) + perm32(R & 31)) : R;
        voffA[i] = (unsigned)(R * K + C) * 2u; voffB[i] = (unsigned)(Rb * K + C) * 2u; }
    const size_t kstep = (size_t)(BK * 2);
    const size_t hstep = (size_t)HALF * K * 2;
    const size_t tstep = 2 * hstep;
    const unsigned ldsw = (unsigned)wid * 1024u;
    const int aoff = lds_byte(wr * 64 + fr, fq * 8), boff = lds_byte(wc * 32 + fr, fq * 8);
#define PG8_SA(b, h) (((b) * 2 + (h)) * HTB)
#define PG8_SB(b, h) ((4 + (b) * 2 + (h)) * HTB)
#define PG8_STAGE(bufoff, gbase, voff) do { _Pragma("unroll") for (int _i = 0; _i < 2; ++_i) \
        __builtin_amdgcn_global_load_lds((const unsigned*)((const char*)(gbase) + (voff)[_i]), (PG8_LAS unsigned*)(lds + (bufoff) + ldsw + _i * 8192), 16, 0, 0); } while (0)
#define PG8_LDA(dst, b, h) do { _Pragma("unroll") for (int m = 0; m < 4; ++m) _Pragma("unroll") for (int k = 0; k < 2; ++k) dst[m][k] = *(const PG8_LAS bf16x8*)(lds + PG8_SA(b, h) + aoff + m * 2048 + k * 1024); } while (0)
#define PG8_LDB(dst, b, h) do { _Pragma("unroll") for (int n = 0; n < 2; ++n) _Pragma("unroll") for (int k = 0; k < 2; ++k) dst[n][k] = *(const PG8_LAS bf16x8*)(lds + PG8_SB(b, h) + boff + n * 2048 + k * 1024); } while (0)
#define PG8_MMA(ai, bj, At, Bt) do { __builtin_amdgcn_s_setprio(1); _Pragma("unroll") for (int m = 0; m < 4; ++m) _Pragma("unroll") for (int n = 0; n < 2; ++n) _Pragma("unroll") for (int k = 0; k < 2; ++k) \
        acc[ai][bj][m][n] = __builtin_amdgcn_mfma_f32_16x16x32_bf16(Bt[n][k], At[m][k], acc[ai][bj][m][n], 0, 0, 0); __builtin_amdgcn_s_setprio(0); } while (0)
#define PG8_WAIT_V(n) asm volatile("s_waitcnt vmcnt(" #n ")" ::: "memory")
#define PG8_WAIT_L(n) asm volatile("s_waitcnt lgkmcnt(" #n ")" ::: "memory")
#define PG8_BAR __builtin_amdgcn_s_barrier()
#define PG8_SCHED __builtin_amdgcn_sched_barrier(0)
    Unit cur, nxt; int ui = 0;
    if (!S.next(0, cur)) return;
    f32x4 acc[2][2][4][2];
#pragma unroll
    for (int a = 0; a < 2; ++a)
#pragma unroll
        for (int b = 0; b < 2; ++b)
#pragma unroll
            for (int m = 0; m < 4; ++m)
#pragma unroll
                for (int n = 0; n < 2; ++n) acc[a][b][m][n] = (f32x4){0.f, 0.f, 0.f, 0.f};
    bf16x8 At[4][2], B0[2][2], B1[2][2];
    const char* cA = (const char*)g.A + (size_t)cur.pm * tstep; const char* cB = (const char*)g.Bt + (size_t)cur.pn * tstep;
    S.a_ready(cur);
    if constexpr (SP2) {
        PG8_STAGE(PG8_SB(0, 0), cB, voffB); PG8_STAGE(PG8_SB(0, 1), cB + hstep, voffB); PG8_STAGE(PG8_SA(0, 0), cA, voffA); PG8_STAGE(PG8_SA(0, 1), cA + hstep, voffA);
        if (wr == 1) PG8_BAR;
        PG8_WAIT_V(2); PG8_BAR;
        PG8_STAGE(PG8_SB(1, 0), cB + kstep, voffB); PG8_STAGE(PG8_SA(1, 0), cA + kstep, voffA); PG8_STAGE(PG8_SB(1, 1), cB + hstep + kstep, voffB);
        PG8_WAIT_V(6); PG8_BAR;
    } else {
        PG8_STAGE(PG8_SB(0, 0), cB, voffB); PG8_STAGE(PG8_SA(0, 0), cA, voffA); PG8_STAGE(PG8_SB(0, 1), cB + hstep, voffB); PG8_STAGE(PG8_SA(0, 1), cA + hstep, voffA);
        if (wr == 1) PG8_BAR;
        PG8_WAIT_V(4); PG8_BAR;
        PG8_STAGE(PG8_SB(1, 0), cB + kstep, voffB); PG8_STAGE(PG8_SA(1, 0), cA + kstep, voffA); PG8_STAGE(PG8_SB(1, 1), cB + hstep + kstep, voffB);
        PG8_WAIT_V(6); PG8_BAR;
    }
    for (;;) {
        const bool has_next = S.next(ui + 1, nxt);
        const char* nA = has_next ? (const char*)g.A + (size_t)nxt.pm * tstep : cA; const char* nB = has_next ? (const char*)g.Bt + (size_t)nxt.pn * tstep : cB;
        for (int t = 0; t < nt; t += 2) {
            const bool last = (t == nt - 2);
            const char* a1 = cA + (size_t)(t + 1) * kstep;
            const char* a2 = last ? nA : cA + (size_t)(t + 2) * kstep; const char* b2 = last ? nB : cB + (size_t)(t + 2) * kstep;
            const char* a3 = a2 + kstep; const char* b3 = b2 + kstep;
            if (last && has_next) S.a_ready(nxt);
            if constexpr (SP2) {
            PG8_LDB(B0, 0, 0); PG8_LDB(B1, 0, 1); PG8_SCHED; PG8_LDA(At, 0, 0); PG8_STAGE(PG8_SA(1, 1), a1 + hstep, voffA);
            PG8_WAIT_V(8); PG8_WAIT_L(0); PG8_BAR; PG8_MMA(0, 0, At, B0); PG8_MMA(0, 1, At, B1); PG8_BAR; PG8_SCHED;
            PG8_LDA(At, 0, 1); PG8_STAGE(PG8_SB(0, 0), b2, voffB); PG8_STAGE(PG8_SB(0, 1), b2 + hstep, voffB); PG8_STAGE(PG8_SA(0, 0), a2, voffA);
            PG8_WAIT_V(8); PG8_WAIT_L(0); PG8_BAR; PG8_MMA(1, 0, At, B0); PG8_MMA(1, 1, At, B1); PG8_BAR; PG8_SCHED;
            PG8_LDB(B0, 1, 0); PG8_LDB(B1, 1, 1); PG8_SCHED; PG8_LDA(At, 1, 0); PG8_STAGE(PG8_SA(0, 1), a2 + hstep, voffA);
            PG8_WAIT_V(8); PG8_WAIT_L(0); PG8_BAR; PG8_MMA(0, 0, At, B0); PG8_MMA(0, 1, At, B1); PG8_BAR; PG8_SCHED;
            PG8_LDA(At, 1, 1); PG8_STAGE(PG8_SB(1, 0), b3, voffB); PG8_STAGE(PG8_SB(1, 1), b3 + hstep, voffB); PG8_STAGE(PG8_SA(1, 0), a3, voffA);
            PG8_WAIT_V(8); PG8_WAIT_L(0); PG8_BAR; PG8_MMA(1, 0, At, B0); PG8_MMA(1, 1, At, B1); PG8_BAR; PG8_SCHED;
            } else {
            PG8_LDB(B0, 0, 0); PG8_SCHED; PG8_LDA(At, 0, 0); PG8_STAGE(PG8_SA(1, 1), a1 + hstep, voffA);
            PG8_WAIT_L(8); PG8_BAR; PG8_WAIT_L(0); PG8_MMA(0, 0, At, B0); PG8_BAR; PG8_SCHED;
            PG8_LDB(B1, 0, 1); PG8_STAGE(PG8_SB(0, 0), b2, voffB);
            PG8_BAR; PG8_WAIT_L(0); PG8_MMA(0, 1, At, B1); PG8_BAR;
            PG8_LDA(At, 0, 1); PG8_STAGE(PG8_SA(0, 0), a2, voffA);
            PG8_BAR; PG8_WAIT_L(0); PG8_MMA(1, 0, At, B0); PG8_BAR; PG8_SCHED;
            PG8_STAGE(PG8_SB(0, 1), b2 + hstep, voffB);
            PG8_WAIT_V(6); PG8_BAR; PG8_MMA(1, 1, At, B1); PG8_BAR;
            PG8_LDB(B0, 1, 0); PG8_SCHED; PG8_LDA(At, 1, 0); PG8_STAGE(PG8_SA(0, 1), a2 + hstep, voffA);
            PG8_WAIT_L(8); PG8_BAR; PG8_WAIT_L(0); PG8_MMA(0, 0, At, B0); PG8_BAR; PG8_SCHED;
            PG8_LDB(B1, 1, 1); PG8_STAGE(PG8_SB(1, 0), b3, voffB);
            PG8_BAR; PG8_WAIT_L(0); PG8_MMA(0, 1, At, B1); PG8_BAR;
            PG8_LDA(At, 1, 1); PG8_STAGE(PG8_SA(1, 0), a3, voffA);
            PG8_BAR; PG8_WAIT_L(0); PG8_MMA(1, 0, At, B0); PG8_BAR; PG8_SCHED;
            PG8_STAGE(PG8_SB(1, 1), b3 + hstep, voffB);
            PG8_WAIT_V(6); PG8_BAR; PG8_MMA(1, 1, At, B1); PG8_BAR;
            }
        }
        if constexpr (ALIGN_EPI) { if (wr == 0) PG8_BAR; }
        if constexpr (!Epi::AFTER_DRAIN) { E(acc, cur, wr, wc, fr, fq); S.done(cur); }
        if (!has_next) break;
#pragma unroll
        for (int a = 0; a < 2; ++a)
#pragma unroll
            for (int b = 0; b < 2; ++b)
#pragma unroll
                for (int m = 0; m < 4; ++m)
#pragma unroll
                    for (int n = 0; n < 2; ++n) acc[a][b][m][n] = (f32x4){0.f, 0.f, 0.f, 0.f};
        cur = nxt; cA = nA; cB = nB; ++ui;
        if constexpr (ALIGN_EPI) { if (wr == 1) PG8_BAR; }
    }
    PG8_WAIT_V(0);
    if constexpr (!ALIGN_EPI) { if (wr == 0) PG8_BAR; }
    PG8_BAR;
    if constexpr (Epi::AFTER_DRAIN) { E.fused(acc, cur, wr, wc, fr, fq, lds, wid, lane); S.done(cur); }
#undef PG8_SA
#undef PG8_SB
#undef PG8_STAGE
#undef PG8_LDA
#undef PG8_LDB
#undef PG8_MMA
#undef PG8_WAIT_V
#undef PG8_WAIT_L
#undef PG8_BAR
#undef PG8_SCHED
}
}
#define LAS __attribute__((address_space(3)))
typedef unsigned short bf16;
typedef float f32x4 __attribute__((ext_vector_type(4)));
typedef unsigned u32x4 __attribute__((ext_vector_type(4)));
typedef unsigned u32x2 __attribute__((ext_vector_type(2)));

constexpr int D = 1024, NB = 8, SEQ = 2048, NL = 2, DECB = 128, NH = 16, HS = 64;
constexpr int DPOOL = 512, PBUF = 15, DFF = 2816, FF2 = 5632, INC = 5888;
constexpr int MP = NB * SEQ, MT = MP + DECB, MPAD = 16640;
constexpr int C_R = 0, C_K = 1024, C_V = 2048, C_WL = 3072, C_POOL = 3328, C_GP = 3840, C_GR = 4864;
constexpr int NMOD = 6 * D, NMOD2 = NL * NMOD;
constexpr float ALPHA = 1.41421356237309515f;
constexpr float LN_EPS = 1e-5f, GN_EPS = 64e-5f;
constexpr int NWAVES = 8, NTHR = 512;

constexpr size_t O_YP = 0, O_YS = 16777216, O_SHP = 16908288, O_WKVP = 16924672, O_POOLP = 17973248, O_CONVP = 18096128,
                 O_SHS = 18276352, O_WKVS = 18538496, O_POOLS = 35315712, O_CONVS = 37281792, O_END = 40165376;

enum { I_XP = 0, I_XS, I_SSHIFT, I_SWKV, I_SPOOL, I_SCONV, I_CP, I_CS, I_ADAW, I_ADAB, I_WIN, I_MU, I_DW0, I_DUP, I_A0, I_AUP, I_GUP,
       I_KK, I_KA, I_RK, I_GNW, I_GNB, I_WBR, I_PW, I_PS, I_WBP, I_WOUT, I_LN1W, I_LN1B, I_UP, I_CW, I_CB, I_DOWN, I_LN2W, I_LN2B, N_IN };

constexpr size_t MiB = 1u << 20;
constexpr size_t SZ_WIN = (size_t)INC * D * 2, SZ_LORA = (size_t)3072 * 256 * 2, SZ_WBR = (size_t)D * D * 2, SZ_PW = (size_t)512 * 512 * 2,
                 SZ_WBP = (size_t)D * 512 * 2, SZ_WOUT = (size_t)D * D * 2, SZ_UP = (size_t)FF2 * D * 2, SZ_DOWN = (size_t)D * DFF * 2;
constexpr size_t WS_WIN = 1 * MiB, WS_LORA = WS_WIN + NL * SZ_WIN, WS_WBR = WS_LORA + NL * SZ_LORA, WS_PW = WS_WBR + NL * SZ_WBR,
                 WS_WBP = WS_PW + NL * SZ_PW, WS_WOUT = WS_WBP + NL * SZ_WBP, WS_UP = WS_WOUT + NL * SZ_WOUT, WS_DOWN = WS_UP + NL * SZ_UP,
                 WS_LBIAS = WS_DOWN + NL * SZ_DOWN, WS_CALL = WS_LBIAS + NL * 3072 * 4, WS_MOD = WS_CALL + 256 * D * 2,
                 WS_RK = WS_MOD + (size_t)256 * NMOD2 * 4, WS_H = WS_RK + (size_t)MPAD * 16 * 4, WS_PROJ = WS_H + (size_t)MPAD * D * 2,
                 WS_AL = WS_PROJ + (size_t)MPAD * INC * 2, WS_PD = WS_AL + (size_t)MPAD * 256 * 2, WS_LO = WS_PD + (size_t)MPAD * 512 * 2,
                 WS_PM = WS_LO + (size_t)MPAD * 3072 * 2, WS_Y = WS_PM + (size_t)MPAD * 512 * 2, WS_XB = WS_Y + (size_t)MPAD * D * 2, WS_R63 = WS_XB + (size_t)MPAD * D * 2, WS_END = WS_R63 + (size_t)(MP / 64) * 3328 * 2;
constexpr size_t WS_ADA = WS_LO, WS_MG = WS_H  , WS_ACT = WS_LO, WS_U = WS_PROJ;
static_assert((size_t)NMOD2 * D * 2 <= (size_t)MPAD * 3072 * 2 && (size_t)MPAD * DFF * 2 <= (size_t)MPAD * 3072 * 2 && (size_t)MPAD * FF2 * 2 <= (size_t)MPAD * INC * 2, "overlays fit");
static_assert(WS_END <= 512 * MiB, "workspace map fits 512 MiB");

constexpr int LDS_BYTES = 147456, MISC_OFF = 140000;
constexpr size_t WS_CTL = 0, CTL_ZERO_BYTES = 131072;

struct Args { const float* in[N_IN]; float* out; unsigned char* ws; int ph_lo, ph_hi; };
typedef const __attribute__((address_space(4))) Args* KArgs;
__device__ __forceinline__ int opqv(int x) { asm volatile("" : "+v"(x)); return x; }
__device__ __forceinline__ int opq(int x) { asm volatile("" : "+s"(x)); return x; }
__device__ __forceinline__ KArgs fresh_args() { KArgs p = (KArgs)__builtin_amdgcn_kernarg_segment_ptr(); asm volatile("" : "+s"(p)); return p; }

__device__ __forceinline__ float bflo(unsigned u) { return __uint_as_float(u << 16); }
__device__ __forceinline__ float bfhi(unsigned u) { return __uint_as_float(u & 0xffff0000u); }
__device__ __forceinline__ float bf1(bf16 b) { return __uint_as_float((unsigned)b << 16); }
typedef float f32x2_t __attribute__((ext_vector_type(2))); typedef __bf16 bf16x2_t __attribute__((ext_vector_type(2)));
__device__ __forceinline__ unsigned pk2(float lo, float hi) { const f32x2_t v = {lo, hi}; const bf16x2_t b = __builtin_convertvector(v, bf16x2_t); return __builtin_bit_cast(unsigned, b); }
struct f8 { f32x4 a, b; };
__device__ __forceinline__ f8 unpack8(u32x4 v) { f8 r; r.a = (f32x4){bflo(v.x), bfhi(v.x), bflo(v.y), bfhi(v.y)}; r.b = (f32x4){bflo(v.z), bfhi(v.z), bflo(v.w), bfhi(v.w)}; return r; }
__device__ __forceinline__ u32x4 pack8(f8 x) { u32x4 r; r.x = pk2(x.a.x, x.a.y); r.y = pk2(x.a.z, x.a.w); r.z = pk2(x.b.x, x.b.y); r.w = pk2(x.b.z, x.b.w); return r; }
__device__ __forceinline__ f32x4 ldnt4(const float* p) { return __builtin_nontemporal_load((const f32x4*)p); }
__device__ __forceinline__ void stnt4(float* p, f32x4 v) { __builtin_nontemporal_store(v, (f32x4*)p); }
__device__ __forceinline__ f8 ld8f(const float* p) { f8 r; r.a = *(const f32x4*)p; r.b = *(const f32x4*)(p + 4); return r; }
__device__ __forceinline__ f8 ld8b(const bf16* p) { return unpack8(*(const u32x4*)p); }
__device__ __forceinline__ f32x4 ld4b(const bf16* p) { const u32x2 v = *(const u32x2*)p; return (f32x4){bflo(v.x), bfhi(v.x), bflo(v.y), bfhi(v.y)}; }
__device__ __forceinline__ f8 zero8() { f8 r; r.a = (f32x4){0.f, 0.f, 0.f, 0.f}; r.b = r.a; return r; }
__device__ __forceinline__ f8 add8(f8 x, f8 y) { f8 r; r.a = x.a + y.a; r.b = x.b + y.b; return r; }
__device__ __forceinline__ f8 sub8(f8 x, f8 y) { f8 r; r.a = x.a - y.a; r.b = x.b - y.b; return r; }
__device__ __forceinline__ f8 mul8(f8 x, f8 y) { f8 r; r.a = x.a * y.a; r.b = x.b * y.b; return r; }
__device__ __forceinline__ f8 scl8(f8 x, float s) { f8 r; r.a = x.a * s; r.b = x.b * s; return r; }
__device__ __forceinline__ f8 mix8(f8 cur, f8 prev, f8 mu) { f8 r; r.a = cur.a + (prev.a - cur.a) * mu.a; r.b = cur.b + (prev.b - cur.b) * mu.b; return r; }
__device__ __forceinline__ float hsum4(f32x4 v) { return (v.x + v.y) + (v.z + v.w); }
__device__ __forceinline__ float hsum8(f8 v) { return hsum4(v.a) + hsum4(v.b); }
__device__ __forceinline__ float sigm(float x) { return __builtin_amdgcn_rcpf(1.0f + __expf(-x)); }
__device__ __forceinline__ f32x4 sigm4(f32x4 v) { return (f32x4){sigm(v.x), sigm(v.y), sigm(v.z), sigm(v.w)}; }
__device__ __forceinline__ f8 sigm8(f8 v) { f8 r; r.a = sigm4(v.a); r.b = sigm4(v.b); return r; }
__device__ __forceinline__ f32x4 exp4(f32x4 v) { return (f32x4){__expf(v.x), __expf(v.y), __expf(v.z), __expf(v.w)}; }
template <int CTRL> __device__ __forceinline__ float dpp_add(float x) { return x + __int_as_float(__builtin_amdgcn_update_dpp(0, __float_as_int(x), CTRL, 0xf, 0xf, true)); }
__device__ __forceinline__ float red8(float x) { x = dpp_add<0xB1>(x); x = dpp_add<0x4E>(x); x = dpp_add<0x141>(x); return x; }
__device__ __forceinline__ float red16(float x) { x = red8(x); x = dpp_add<0x140>(x); return x; }
__device__ __forceinline__ float wave_sum(float v) {
    v = red16(v);
    const float r0 = __int_as_float(__builtin_amdgcn_readlane(__float_as_int(v), 0)), r1 = __int_as_float(__builtin_amdgcn_readlane(__float_as_int(v), 16)),
                r2 = __int_as_float(__builtin_amdgcn_readlane(__float_as_int(v), 32)), r3 = __int_as_float(__builtin_amdgcn_readlane(__float_as_int(v), 48));
    return (r0 + r1) + (r2 + r3);
}
__device__ __forceinline__ int cidx_of(int m) { return m < MP ? (m >> 11) : (NB + (m - MP)); }
__device__ __forceinline__ int prev_row(int m) { return m < MP ? (((m & (SEQ - 1)) > 0) ? m - 1 : -1) : m + DECB; }

struct EpiF32Bias {
    static constexpr bool PERM = false, AFTER_DRAIN = false;
    float* O; int ldc; const float* bias;
    __device__ __forceinline__ void operator()(const pg8::f32x4 (&acc)[2][2][4][2], const pg8::Unit& u, int wr, int wc, int fr, int fq) const {
        const int row0 = u.pm * 256 + wr * 64 + fr, col0 = u.pn * 256 + wc * 32 + 4 * fq;
#pragma unroll
        for (int ai = 0; ai < 2; ++ai)
#pragma unroll
            for (int m = 0; m < 4; ++m) { float* rowp = O + (size_t)(row0 + ai * 128 + m * 16) * ldc + col0;
#pragma unroll
                for (int bj = 0; bj < 2; ++bj)
#pragma unroll
                    for (int n = 0; n < 2; ++n) { const f32x4 bv = *(const f32x4*)(bias + col0 + bj * 128 + n * 16); *(f32x4*)(rowp + bj * 128 + n * 16) = acc[ai][bj][m][n] + bv; } }
    }
};
template <int CTRL> __device__ __forceinline__ float dpp_mov(float x) { return __int_as_float(__builtin_amdgcn_update_dpp(0, __float_as_int(x), CTRL, 0xf, 0xf, true)); }
template <int CTRL> __device__ __forceinline__ f32x4 dpp_mov4(f32x4 v) { return (f32x4){dpp_mov<CTRL>(v.x), dpp_mov<CTRL>(v.y), dpp_mov<CTRL>(v.z), dpp_mov<CTRL>(v.w)}; }
template <int CTRL> __device__ __forceinline__ f32x4 dpp_upd4(f32x4 old, f32x4 v) {
    return (f32x4){__int_as_float(__builtin_amdgcn_update_dpp(__float_as_int(old.x), __float_as_int(v.x), CTRL, 0xf, 0xf, false)), __int_as_float(__builtin_amdgcn_update_dpp(__float_as_int(old.y), __float_as_int(v.y), CTRL, 0xf, 0xf, false)),
                   __int_as_float(__builtin_amdgcn_update_dpp(__float_as_int(old.z), __float_as_int(v.z), CTRL, 0xf, 0xf, false)), __int_as_float(__builtin_amdgcn_update_dpp(__float_as_int(old.w), __float_as_int(v.w), CTRL, 0xf, 0xf, false))};
}
struct EpiConv {
    static constexpr bool PERM = true, AFTER_DRAIN = false;
    bf16* U; bf16* ACT; const float* cw; const float* cb;
    __device__ __forceinline__ void operator()(const pg8::f32x4 (&acc)[2][2][4][2], const pg8::Unit& u, int wr, int wc, int fr, int fq) const {
        const int rowb = u.pm * 256 + wr * 64 + fr, cl = wc * 32 + 8 * fq, f = u.pn * 128 + cl, ucol = u.pn * 256 + cl; const bool tail = (u.pm == MP / 256);
#pragma unroll
        for (int ai = 0; ai < 2; ++ai)
#pragma unroll
            for (int m = 0; m < 4; ++m) { const int row = rowb + ai * 128 + m * 16;
                if (tail ? (row < MT) : ((m == 0 && fr < 2) || (m == 3 && fr >= 14))) { f8 v; v.a = acc[ai][0][m][0]; v.b = acc[ai][0][m][1]; f8 g; g.a = acc[ai][1][m][0]; g.b = acc[ai][1][m][1];
                    bf16* up = U + (size_t)row * FF2 + ucol; *(u32x4*)up = pack8(v); *(u32x4*)(up + 128) = pack8(g); }
                if (!tail) { f8 o;
#pragma unroll
                    for (int n = 0; n < 2; ++n) { const f32x4 v2 = acc[ai][0][m][n], g2 = acc[ai][1][m][n]; f32x4 v1, v0, g1, g0;
                        if (m == 0) { v1 = dpp_mov4<0x111>(v2); v0 = dpp_mov4<0x112>(v2); g1 = dpp_mov4<0x111>(g2); g0 = dpp_mov4<0x112>(g2); }
                        else { const f32x4 pv = acc[ai][0][m > 0 ? m - 1 : 0][n], pg = acc[ai][1][m > 0 ? m - 1 : 0][n];
                            v1 = dpp_upd4<0x111>(dpp_mov4<0x121>(pv), v2); v0 = dpp_upd4<0x112>(dpp_mov4<0x122>(pv), v2);
                            g1 = dpp_upd4<0x111>(dpp_mov4<0x121>(pg), g2); g0 = dpp_upd4<0x112>(dpp_mov4<0x122>(pg), g2); }
                        const float* wp = cw + f + 4 * n; const float* bp = cb + f + 4 * n;
                        const f32x4 cv = *(const f32x4*)bp + v0 * *(const f32x4*)wp + v1 * *(const f32x4*)(wp + FF2) + v2 * *(const f32x4*)(wp + 2 * FF2);
                        const f32x4 cg = *(const f32x4*)(bp + DFF) + g0 * *(const f32x4*)(wp + DFF) + g1 * *(const f32x4*)(wp + FF2 + DFF) + g2 * *(const f32x4*)(wp + 2 * FF2 + DFF);
                        const f32x4 r = cv * cg * sigm4(cg); if (n == 0) o.a = r; else o.b = r; }
                    if (m > 0 || fr >= 2) *(u32x4*)(ACT + (size_t)row * DFF + f) = pack8(o); }
                asm volatile("" ::: "memory"); }
    }
};
struct EpiProj {
    static constexpr bool PERM = true, AFTER_DRAIN = false;
    bf16* PROJ; bf16* AL; bf16* R63; const float* mu;
    __device__ __forceinline__ void operator()(const pg8::f32x4 (&acc)[2][2][4][2], const pg8::Unit& u, int wr, int wc, int fr, int fq) const {
        const int rowb = u.pm * 256 + wr * 64 + fr, cl = wc * 32 + 8 * fq, col0 = u.pn * 256 + cl; const bool tail = (u.pm == MP / 256);
        if (u.pn > 12) {
#pragma unroll
            for (int ai = 0; ai < 2; ++ai)
#pragma unroll
                for (int m = 0; m < 4; ++m)
#pragma unroll
                    for (int bj = 0; bj < 2; ++bj) { f8 v; v.a = acc[ai][bj][m][0]; v.b = acc[ai][bj][m][1]; *(u32x4*)(PROJ + (size_t)(rowb + ai * 128 + m * 16) * INC + col0 + bj * 128) = pack8(v); }
            return; }
#pragma unroll
        for (int bj = 0; bj < 2; ++bj) { const int col = col0 + bj * 128; const f8 m8 = ld8f(mu + col);
#pragma unroll
            for (int ai = 0; ai < 2; ++ai)
#pragma unroll
                for (int m = 0; m < 4; ++m) { const int row = rowb + ai * 128 + m * 16;
                    f8 cur; cur.a = acc[ai][bj][m][0]; cur.b = acc[ai][bj][m][1]; f8 prev; bool raw;
                    if (tail) { prev.a = acc[1][bj][m][0]; prev.b = acc[1][bj][m][1]; raw = false; }
                    else if (m == 0) { prev.a = dpp_mov4<0x111>(cur.a); prev.b = dpp_mov4<0x111>(cur.b); raw = (fr == 0); }
                    else { prev.a = dpp_upd4<0x111>(dpp_mov4<0x121>(acc[ai][bj][m > 0 ? m - 1 : 0][0]), cur.a); prev.b = dpp_upd4<0x111>(dpp_mov4<0x121>(acc[ai][bj][m > 0 ? m - 1 : 0][1]), cur.b); raw = false; }
                    if (tail && ai == 1) continue;
                    if (!tail && m == 3 && fr == 15) *(u32x4*)(R63 + (size_t)(row >> 6) * 3328 + col) = pack8(cur);
                    f8 xs = mix8(cur, prev, m8);
                    if (raw) { *(u32x4*)(PROJ + (size_t)row * INC + col) = pack8(cur); }
                    else if (u.pn < 12) { *(u32x4*)(PROJ + (size_t)row * INC + col) = pack8(xs); }
                    else { if (bj == 0) { if (wc < 2) { xs = sigm8(scl8(xs, 2.0f)); xs.a = xs.a * 2.0f - 1.0f; xs.b = xs.b * 2.0f - 1.0f; } } else xs = sigm8(xs);
                        *(u32x4*)(AL + (size_t)row * 256 + cl + bj * 128) = pack8(xs); }
                    asm volatile("" ::: "memory"); } }
    }
};
struct EpiGate {
    static constexpr bool PERM = true, AFTER_DRAIN = false;
    const bf16* gate; int ldg; bf16* out; int ldo; int accumulate;
    __device__ __forceinline__ void operator()(const pg8::f32x4 (&acc)[2][2][4][2], const pg8::Unit& u, int wr, int wc, int fr, int fq) const {
        const int row0 = u.pm * 256 + wr * 64 + fr, col0 = u.pn * 256 + wc * 32 + 8 * fq;
#pragma unroll
        for (int ai = 0; ai < 2; ++ai)
#pragma unroll
            for (int m = 0; m < 4; ++m) { const int row = row0 + ai * 128 + m * 16;
#pragma unroll
                for (int bj = 0; bj < 2; ++bj) { const int col = col0 + bj * 128;
                    f8 g = sigm8(ld8b(gate + (size_t)row * ldg + col)); f8 v; v.a = acc[ai][bj][m][0] * g.a; v.b = acc[ai][bj][m][1] * g.b;
                    bf16* op = out + (size_t)row * ldo + col;
                    if (accumulate) v = add8(v, ld8b(op));
                    *(u32x4*)op = pack8(v); }
                asm volatile("" ::: "memory"); }
    }
};
struct EpiRes {
    static constexpr bool PERM = true, AFTER_DRAIN = false;
    bf16* X; const float* mod;
    __device__ __forceinline__ void operator()(const pg8::f32x4 (&acc)[2][2][4][2], const pg8::Unit& u, int wr, int wc, int fr, int fq) const {
        const int row0 = u.pm * 256 + wr * 64 + fr, col0 = u.pn * 256 + wc * 32 + 8 * fq;
#pragma unroll
        for (int ai = 0; ai < 2; ++ai)
#pragma unroll
            for (int m = 0; m < 4; ++m) { const int row = row0 + ai * 128 + m * 16;
                if (row < MT) { bf16* xp = X + (size_t)row * D + col0; const float* gp = mod + (size_t)cidx_of(row) * NMOD2 + col0;
#pragma unroll
                    for (int bj = 0; bj < 2; ++bj) { const int o = bj * 128; const f8 x = ld8b(xp + o); const f8 g = ld8f(gp + o);
                        f8 r; r.a = x.a * ALPHA + (g.a + 1.0f) * acc[ai][bj][m][0]; r.b = x.b * ALPHA + (g.b + 1.0f) * acc[ai][bj][m][1];
                        *(u32x4*)(xp + o) = pack8(r); } } }
    }
};

__device__ __forceinline__ void tr_item(const float* W, int ldw, bf16* WT, int ldk, int k0, int n0, const float* rowscale, LAS float* scr, int lane) {
#pragma unroll
    for (int i = 0; i < 8; ++i) { const int kk = 8 * i + (lane >> 3), nq = (lane & 7) * 4;
        const f32x4 v = ldnt4(W + (size_t)(k0 + kk) * ldw + n0 + nq); LAS float* d = scr + kk * 33 + nq; d[0] = v.x; d[1] = v.y; d[2] = v.z; d[3] = v.w; }
    asm volatile("s_waitcnt lgkmcnt(0)" ::: "memory");
    const int c = lane & 7;
#pragma unroll
    for (int j = 0; j < 4; ++j) { const int n = (lane >> 3) + 8 * j; const LAS float* s = scr + (8 * c) * 33 + n; const float sc = rowscale ? rowscale[n0 + n] : 1.0f;
        u32x4 o; o.x = pk2(s[0 * 33] * sc, s[1 * 33] * sc); o.y = pk2(s[2 * 33] * sc, s[3 * 33] * sc); o.z = pk2(s[4 * 33] * sc, s[5 * 33] * sc); o.w = pk2(s[6 * 33] * sc, s[7 * 33] * sc);
        *(u32x4*)(WT + (size_t)(n0 + n) * ldk + k0 + 8 * c) = o; }
    asm volatile("s_waitcnt lgkmcnt(0)" ::: "memory");
}
__device__ __forceinline__ void phase_prep(KArgs ap, LAS unsigned char* lds, int tid, int lane, int wave, int bid, int G, int mode) {
    static_assert(NL == 2, "the weight-conversion schedule is written for two layers");
    unsigned char* ws = ap->ws;
    LAS float* scr = (LAS float*)(lds + wave * 16384);
    const int gw = bid * NWAVES + wave, NGW = G * NWAVES;
    constexpr int PER_L = 2944 + 3072 + 32 + 32 + 64 + 512 + 32 + 256 + 512 + 2816 + 1408;
    constexpr int N_FFN = 2816 + 1408, N_OTH = PER_L - 3072 - N_FFN;
    const int nitems = mode == 0 ? 2 * 3072 : (mode == 1 ? N_OTH : (mode == 3 ? N_FFN : PER_L - 3072));
    for (int it0 = gw; it0 < nitems; it0 += NGW) {
        int l, r; const int it = (mode == 3) ? it0 + N_OTH : it0;
        if (mode == 0) { l = it / 3072; r = 2944 + it % 3072; }
        else { l = (mode == 2) ? 0 : 1; r = it < 2944 ? it : it + 3072; }
#define TR(NKB, NNB, Wp, ldw, WTp, ldk, rs) if (r < (NKB) * (NNB)) { const int kb = r / (NNB), nb = r % (NNB); tr_item((Wp), (ldw), (WTp), (ldk), kb * 64, nb * 32, (rs), scr, lane); continue; } r -= (NKB) * (NNB);
        TR(16, 184, ap->in[I_WIN] + (size_t)l * D * INC, INC, (bf16*)(ws + WS_WIN + l * SZ_WIN), D, nullptr)
        TR(16, 192, ap->in[I_ADAW] + (size_t)l * D * NMOD, NMOD, (bf16*)(ws + WS_ADA) + (size_t)l * NMOD * D, D, nullptr)
        TR(1, 32, ap->in[I_DUP] + (size_t)l * 64 * D, D, (bf16*)(ws + WS_LORA + l * SZ_LORA), 256, nullptr)
        TR(1, 32, ap->in[I_AUP] + (size_t)l * 64 * D, D, (bf16*)(ws + WS_LORA + l * SZ_LORA) + 1024 * 256 + 64, 256, nullptr)
        TR(2, 32, ap->in[I_GUP] + (size_t)l * 128 * D, D, (bf16*)(ws + WS_LORA + l * SZ_LORA) + 2048 * 256 + 128, 256, nullptr)
        TR(16, 32, ap->in[I_WBR] + (size_t)l * D * D, D, (bf16*)(ws + WS_WBR + l * SZ_WBR), D, nullptr)
        if (r < 32) { const int g = r >> 3, q = r & 7, kb = q >> 2, nb = q & 3;
            tr_item(ap->in[I_PW] + (size_t)(l * 4 + g) * 128 * 128, 128, (bf16*)(ws + WS_PW + l * SZ_PW) + (size_t)(g * 128) * 512 + g * 128, 512, kb * 64, nb * 32, ap->in[I_PS] + l * 512 + g * 128, scr, lane); continue; } r -= 32;
        TR(8, 32, ap->in[I_WBP] + (size_t)l * 512 * D, D, (bf16*)(ws + WS_WBP + l * SZ_WBP), 512, nullptr)
        TR(16, 32, ap->in[I_WOUT] + (size_t)l * D * D, D, (bf16*)(ws + WS_WOUT + l * SZ_WOUT), D, nullptr)
        if (r < 16 * 176) { const int kb = r / 176, n0 = (r % 176) * 32;
            const int pn0 = n0 < DFF ? (n0 / 128) * 256 + (n0 % 128) : ((n0 - DFF) / 128) * 256 + 128 + ((n0 - DFF) % 128);
            tr_item(ap->in[I_UP] + (size_t)l * D * FF2, FF2, (bf16*)(ws + WS_UP + l * SZ_UP) + (ptrdiff_t)(pn0 - n0) * D, D, kb * 64, n0, nullptr, scr, lane); continue; } r -= 16 * 176;
        TR(44, 32, ap->in[I_DOWN] + (size_t)l * DFF * D, D, (bf16*)(ws + WS_DOWN + l * SZ_DOWN), DFF, nullptr)
#undef TR
    }
    if (mode != 0) return;
    const int gt = bid * NTHR + tid, NGT = G * NTHR;
    const u32x4 z4 = (u32x4){0u, 0u, 0u, 0u};
    for (int i = gt; i < NL * 3072 * 32; i += NGT) { const int l = i / (3072 * 32), r = i % (3072 * 32), n = r >> 5, c = r & 31, blk = n >> 10;
        const bool diag = (blk == 0) ? (c < 8) : (blk == 1) ? (c >= 8 && c < 16) : (c >= 16);
        if (!diag) *(u32x4*)((bf16*)(ws + WS_LORA + l * SZ_LORA) + (size_t)n * 256 + c * 8) = z4; }
    for (int i = gt; i < NL * 512 * 64; i += NGT) { const int l = i / (512 * 64), r = i % (512 * 64), n = r >> 6, c = r & 63, g = n >> 7;
        if ((c >> 4) != g) *(u32x4*)((bf16*)(ws + WS_PW + l * SZ_PW) + (size_t)n * 512 + c * 8) = z4; }
    for (int i = gt; i < NL * 3072; i += NGT) { const int l = i / 3072, c = i % 3072;
        ((float*)(ws + WS_LBIAS))[i] = c < 1024 ? ap->in[I_DW0][l * D + c] : (c < 2048 ? ap->in[I_A0][l * D + c - 1024] : 0.f); }
    for (int i = gt; i < 256 * D / 2; i += NGT) { const int row = i / (D / 2), c = (i % (D / 2)) * 2; float v0 = 0.f, v1 = 0.f;
        if (row < NB) { v0 = ap->in[I_CP][row * D + c]; v1 = ap->in[I_CP][row * D + c + 1]; } else if (row < NB + DECB) { v0 = ap->in[I_CS][(row - NB) * D + c]; v1 = ap->in[I_CS][(row - NB) * D + c + 1]; }
        ((unsigned*)(ws + WS_CALL))[i] = pk2(v0, v1); }
}

__device__ __forceinline__ void rowpass_load(KArgs ap, int stage, int m, int lane, f32x4 (&v)[4]) {
    if (stage == 0) { const float* src = (m < MP ? ap->in[I_XP] + (size_t)m * D : ap->in[I_XS] + (size_t)(m - MP) * D);
#pragma unroll
        for (int j = 0; j < 2; ++j) { v[2 * j] = ldnt4(src + 8 * lane + 512 * j); v[2 * j + 1] = ldnt4(src + 8 * lane + 512 * j + 4); } }
    else { const bf16* src = (const bf16*)(ap->ws + WS_XB) + (size_t)m * D;
#pragma unroll
        for (int j = 0; j < 2; ++j) { const f8 t = ld8b(src + 8 * lane + 512 * j); v[2 * j] = t.a; v[2 * j + 1] = t.b; } }
}
__device__ __forceinline__ void phase_rowpass(KArgs ap, int stage, int l, int lane, int gw, int NGW, int mfirst, int mstep, int mend, bool do_shift) {
    unsigned char* ws = ap->ws; float* X = ap->out; bf16* H = (bf16*)(ws + WS_H); const float* MOD = (const float*)(ws + WS_MOD);
    if (do_shift && (stage == 0 || stage == 2))
        for (int m = MT + gw; m < MPAD; m += NGW) { const float* src = ap->in[I_SSHIFT] + ((size_t)l * DECB + (m - MT)) * D;
#pragma unroll
            for (int j = 0; j < 2; ++j) { f8 t; t.a = *(const f32x4*)(src + 8 * lane + 512 * j); t.b = *(const f32x4*)(src + 8 * lane + 512 * j + 4); *(u32x4*)(H + (size_t)m * D + 8 * lane + 512 * j) = pack8(t); } }
    const float* lw = (stage == 1) ? ap->in[I_LN1W] + l * D : ap->in[I_LN2W] + (l - 1) * D;
    const float* lb = (stage == 1) ? ap->in[I_LN1B] + l * D : ap->in[I_LN2B] + (l - 1) * D;
    f32x4 vn[4];
    if (mfirst < mend) rowpass_load(ap, stage, mfirst, lane, vn);
    for (int m = mfirst; m < mend; m += mstep) {
        f32x4 v[4];
#pragma unroll
        for (int j = 0; j < 4; ++j) v[j] = vn[j];
        if (m + mstep < mend) rowpass_load(ap, stage, m + mstep, lane, vn);
        if (stage != 0) {
            float s = 0.f;
#pragma unroll
            for (int j = 0; j < 4; ++j) s += hsum4(v[j]);
            const float mean = wave_sum(s) * (1.f / D); float q = 0.f;
#pragma unroll
            for (int j = 0; j < 4; ++j) { v[j] = v[j] - mean; q += hsum4(v[j] * v[j]); }
            const float rstd = 1.0f / sqrtf(wave_sum(q) * (1.f / D) + LN_EPS);
#pragma unroll
            for (int j = 0; j < 4; ++j) { const int c = 8 * lane + 512 * (j >> 1) + 4 * (j & 1); v[j] = v[j] * rstd * *(const f32x4*)(lw + c) + *(const f32x4*)(lb + c); }
        }
        if (stage == 3) {
#pragma unroll
            for (int j = 0; j < 4; ++j) stnt4(X + (size_t)m * D + 8 * lane + 512 * (j >> 1) + 4 * (j & 1), v[j]);
            continue; }
#pragma unroll
        for (int j = 0; j < 2; ++j) { f8 t; t.a = v[2 * j]; t.b = v[2 * j + 1]; *(u32x4*)((bf16*)(ws + WS_XB) + (size_t)m * D + 8 * lane + 512 * j) = pack8(t); }
        float s = 0.f;
#pragma unroll
        for (int j = 0; j < 4; ++j) s += hsum4(v[j]);
        const float mean = wave_sum(s) * (1.f / D); float q = 0.f;
#pragma unroll
        for (int j = 0; j < 4; ++j) { v[j] = v[j] - mean; q += hsum4(v[j] * v[j]); }
        const float rstd = 1.0f / sqrtf(wave_sum(q) * (1.f / D) + LN_EPS);
        const float* sh = MOD + (size_t)cidx_of(m) * NMOD2 + l * NMOD + (stage == 1 ? 3 * D : 0); const float* sc = sh + D;
        float* so = nullptr;
        if (stage != 1) { if (m >= MP) so = ap->out + O_SHS + ((size_t)l * DECB + (m - MP)) * D; else if ((m & (SEQ - 1)) == SEQ - 1) so = ap->out + O_SHP + ((size_t)l * NB + (m >> 11)) * D; }
#pragma unroll
        for (int j = 0; j < 2; ++j) { const int c = 8 * lane + 512 * j; f8 h;
            h.a = v[2 * j] * rstd * (*(const f32x4*)(sc + c) + 1.0f) + *(const f32x4*)(sh + c); h.b = v[2 * j + 1] * rstd * (*(const f32x4*)(sc + c + 4) + 1.0f) + *(const f32x4*)(sh + c + 4);
            *(u32x4*)(H + (size_t)m * D + c) = pack8(h);
            if (so) { stnt4(so + c, h.a); stnt4(so + c + 4, h.b); } }
    }
}

__device__ __forceinline__ void phase_prepC(KArgs ap, int l, int gt, int NGT) {
    unsigned char* ws = ap->ws; const bf16* PROJ = (const bf16*)(ws + WS_PROJ); bf16* AL = (bf16*)(ws + WS_AL); bf16* PD = (bf16*)(ws + WS_PD);
    const float* mu = ap->in[I_MU] + (size_t)l * 3328 + C_WL; const float* spool = ap->in[I_SPOOL] + (size_t)l * DECB * PBUF * DPOOL;
    constexpr int RR = 8;
    for (int idx = gt; idx < (MP / RR) * 64; idx += NGT) {
        const int rr = idx >> 6, j0 = (idx & 63) * 8, g = j0 >> 7, win = 2 << g, m0 = rr * RR, t0 = m0 & (SEQ - 1);
        const bf16* pp = PROJ + (size_t)m0 * INC + C_POOL + j0;
        f8 acc = zero8();
        for (int i = 1; i < win; ++i) if (t0 - i >= 0) acc = add8(acc, ld8b(pp - (size_t)i * INC));
#pragma unroll 4
        for (int i = 0; i < RR; ++i) {
            const int t = t0 + i; const f8 cur = ld8b(pp + (size_t)i * INC);
            acc = add8(acc, cur);
            const int n = (t + 1 < win) ? t + 1 : win; const float ic = 1.0f / (float)n;
            f8 d; d.a = acc.a * ic - cur.a; d.b = acc.b * ic - cur.b;
            *(u32x4*)(PD + (size_t)(m0 + i) * 512 + j0) = pack8(d);
            if (t - win + 1 >= 0) acc = sub8(acc, ld8b(pp + ((long)i - win + 1) * INC));
        }
    }
    for (int idx = gt; idx < DECB * 64; idx += NGT) {
        const int m = MP + (idx >> 6), j0 = (idx & 63) * 8, g = j0 >> 7, win = 2 << g; const f8 cur = ld8b(PROJ + (size_t)m * INC + C_POOL + j0); f8 acc = cur;
        const float* sp = spool + (size_t)(m - MP) * PBUF * DPOOL + j0;
        for (int i = 1; i < win; ++i) acc = add8(acc, ld8f(sp + (size_t)(PBUF - i) * DPOOL));
        const float ic = 1.0f / (float)win; f8 d; d.a = acc.a * ic - cur.a; d.b = acc.b * ic - cur.b;
        *(u32x4*)(PD + (size_t)m * 512 + j0) = pack8(d);
    }
    for (int idx = gt; idx < NB * PBUF * 64; idx += NGT) { const int c = idx & 63, i = (idx >> 6) % PBUF, b = idx / (64 * PBUF);
        const f8 v = ld8b(PROJ + (size_t)(b * SEQ + SEQ - PBUF + i) * INC + C_POOL + c * 8); float* o = ap->out + O_POOLP + (((size_t)l * NB + b) * PBUF + i) * DPOOL + c * 8;
        stnt4(o, v.a); stnt4(o + 4, v.b); }
    for (int idx = gt; idx < DECB * PBUF * 64; idx += NGT) { const int c = idx & 63, i = (idx >> 6) % PBUF, b = idx / (64 * PBUF);
        const f8 v = (i < PBUF - 1) ? ld8f(spool + ((size_t)b * PBUF + i + 1) * DPOOL + c * 8) : ld8b(PROJ + (size_t)(MP + b) * INC + C_POOL + c * 8);
        float* o = ap->out + O_POOLS + (((size_t)l * DECB + b) * PBUF + i) * DPOOL + c * 8; stnt4(o, v.a); stnt4(o + 4, v.b); }
}

struct ScanRaw { u32x4 cr, ck, cv, pr, pk, pv, dd, aa, gg; };
__device__ __forceinline__ ScanRaw scan_load(const bf16* PROJ, const bf16* LO, const bf16* R63g, int m, int cofs, bool has_prev) {
    ScanRaw r; const bf16* p = PROJ + (size_t)m * INC + cofs; const u32x4 z = (u32x4){0u, 0u, 0u, 0u};
    r.cr = __builtin_nontemporal_load((const u32x4*)(p + C_R)); r.ck = __builtin_nontemporal_load((const u32x4*)(p + C_K)); r.cv = __builtin_nontemporal_load((const u32x4*)(p + C_V));
    r.pr = z; r.pk = z; r.pv = z;
    if (has_prev) { const bf16* q = R63g + (size_t)((m >> 6) - 1) * 3328 + cofs; r.pr = __builtin_nontemporal_load((const u32x4*)(q + C_R)); r.pk = __builtin_nontemporal_load((const u32x4*)(q + C_K)); r.pv = __builtin_nontemporal_load((const u32x4*)(q + C_V)); }
    const bf16* q = LO + (size_t)m * 3072 + cofs; r.dd = __builtin_nontemporal_load((const u32x4*)q); r.aa = __builtin_nontemporal_load((const u32x4*)(q + 1024)); r.gg = __builtin_nontemporal_load((const u32x4*)(q + 2048));
    return r;
}
__device__ __forceinline__ void st8lds(LAS float* p, f8 v) { *(LAS f32x4*)p = v.a; *(LAS f32x4*)(p + 4) = v.b; }
__device__ __forceinline__ f8 ld8lds(const LAS float* p) { f8 r; r.a = *(const LAS f32x4*)p; r.b = *(const LAS f32x4*)(p + 4); return r; }
__device__ __forceinline__ void phase_scan(KArgs ap, int l, LAS unsigned char* lds, int tid, int lane, int wave, int bid, int G) {
    unsigned char* ws = ap->ws; const bf16* PROJ = (const bf16*)(ws + WS_PROJ); const bf16* LO = (const bf16*)(ws + WS_LO); bf16* Y = (bf16*)(ws + WS_Y); float* RK = (float*)(ws + WS_RK);
    LAS float* vec = (LAS float*)lds; LAS float* yb = (LAS float*)(lds + 98304); LAS float* cst = (LAS float*)(lds + 106496);
    const float* mu = ap->in[I_MU] + (size_t)l * 3328;
    {
        typedef short bf16x4 __attribute__((ext_vector_type(4)));
        constexpr int L_LW = 0, L_GC = 16384, L_GCLOG = 17408, L_CST = 18432, L_CH = 20480, CHB = 22784;
        constexpr int C_KT = 0, C_RT = 2304, C_BT = 4608, C_KK = 6912, C_KG = 9216, C_BG = 12288, C_VT = 15360, C_AKK = 18432, C_BBR = 19200, C_BKR = 19968, C_TT = 20736, C_AKB = 21504;
        LAS float* YR = (LAS float*)(lds + 112640);
        LAS float* LW = (LAS float*)(lds + L_LW); LAS float* GCx = (LAS float*)(lds + L_GC); LAS float* GCL = (LAS float*)(lds + L_GCLOG); LAS float* cs2 = (LAS float*)(lds + L_CST);
#define CHP(cq, off) ((LAS bf16*)(lds + L_CH + (cq) * CHB + (off)))
#define BARRIER() asm volatile("s_waitcnt lgkmcnt(0)\n\ts_barrier" ::: "memory")
        const int nitems = NB * NH;
        for (int item = bid; item < nitems; item += G) {
            const int b = item >> 4, h = item & 15, mbase = b * SEQ;
            __syncthreads();
            if (tid < 64) { const int c = h * 64 + tid;
                cs2[tid] = mu[C_R + c]; cs2[64 + tid] = mu[C_K + c]; cs2[128 + tid] = mu[C_V + c];
                cs2[192 + tid] = ap->in[I_KK][l * D + c]; cs2[256 + tid] = ap->in[I_KA][l * D + c]; cs2[320 + tid] = ap->in[I_RK][l * D + c];
                cs2[384 + tid] = ap->in[I_GNW][l * D + c]; cs2[448 + tid] = ap->in[I_GNB][l * D + c]; }
            __syncthreads();
            const int tt = tid >> 3, jo = tid & 7, cofs = h * 64 + jo * 8, cq = tt >> 4, tl = tt & 15;
            const int li = lane & 15, lq = lane >> 4;
            const f32x4 z4 = (f32x4){0.f, 0.f, 0.f, 0.f};
            f32x4 S0 = z4, S1 = z4, S2 = z4, S3 = z4;
            const bf16* R63g = (const bf16*)(ws + WS_R63);
            ScanRaw raw = scan_load(PROJ, LO, R63g, mbase + tt, cofs, false);
            for (int sc = 0; sc < SEQ / 64; ++sc) {
                const int m0 = mbase + sc * 64;
                f8 r8 = unpack8(raw.cr), k8 = unpack8(raw.ck), v8 = unpack8(raw.cv);
                if (tt == 0) { r8 = mix8(r8, unpack8(raw.pr), ld8lds(cs2 + jo * 8)); k8 = mix8(k8, unpack8(raw.pk), ld8lds(cs2 + 64 + jo * 8)); v8 = mix8(v8, unpack8(raw.pv), ld8lds(cs2 + 128 + jo * 8)); }
                const f8 lw8 = scl8(sigm8(unpack8(raw.dd)), -0.60653065971f);
                const f8 av = sigm8(unpack8(raw.aa)); const u32x4 gate_raw = raw.gg;
                if (sc + 1 < SEQ / 64) raw = scan_load(PROJ, LO, R63g, m0 + 64 + tt, cofs, tt == 0);
                f8 kk8 = mul8(k8, ld8lds(cs2 + 192 + jo * 8));
                { const float ss = red8(hsum8(mul8(kk8, kk8))); kk8 = scl8(kk8, 1.0f / fmaxf(sqrtf(ss), 1e-12f)); }
                const f8 ka = ld8lds(cs2 + 256 + jo * 8); f8 kp8; kp8.a = k8.a * ((av.a - 1.0f) * ka.a + 1.0f); kp8.b = k8.b * ((av.b - 1.0f) * ka.b + 1.0f);
                const f8 bb8 = mul8(kk8, av);
                const float rk = red8(hsum8(mul8(mul8(r8, kp8), ld8lds(cs2 + 320 + jo * 8))));
                st8lds(LW + tt * 64 + jo * 8, lw8);
                { LAS bf16* vt = CHP(cq, C_VT) + (jo * 8) * 24 + tl;
                  const u32x4 pv = pack8(v8);
                  vt[0 * 24] = (bf16)(pv.x & 0xffffu); vt[1 * 24] = (bf16)(pv.x >> 16); vt[2 * 24] = (bf16)(pv.y & 0xffffu); vt[3 * 24] = (bf16)(pv.y >> 16);
                  vt[4 * 24] = (bf16)(pv.z & 0xffffu); vt[5 * 24] = (bf16)(pv.z >> 16); vt[6 * 24] = (bf16)(pv.w & 0xffffu); vt[7 * 24] = (bf16)(pv.w >> 16); }
                BARRIER();
                if (tid < 256) { const int q = tid >> 6, k = tid & 63; float gv[16];
#pragma unroll
                    for (int t = 0; t < 16; ++t) gv[t] = LW[(q * 16 + t) * 64 + k];
#pragma unroll
                    for (int t = 1; t < 16; ++t) gv[t] += gv[t - 1];
#pragma unroll
                    for (int t = 0; t < 16; ++t) { gv[t] = __expf(gv[t]); LW[(q * 16 + t) * 64 + k] = gv[t]; }
                    GCL[q * 64 + k] = gv[15]; GCx[q * 64 + k] = gv[15]; }
                BARRIER();
                {   const f8 e = ld8lds(LW + tt * 64 + jo * 8); f8 ep; ep.a = (f32x4){1.f, 1.f, 1.f, 1.f}; ep.b = ep.a; if (tl > 0) ep = ld8lds(LW + (tt - 1) * 64 + jo * 8); const f8 gc = ld8lds(GCx + cq * 64 + jo * 8);
                    f8 ie; ie.a = (f32x4){__builtin_amdgcn_rcpf(e.a.x), __builtin_amdgcn_rcpf(e.a.y), __builtin_amdgcn_rcpf(e.a.z), __builtin_amdgcn_rcpf(e.a.w)};
                    ie.b = (f32x4){__builtin_amdgcn_rcpf(e.b.x), __builtin_amdgcn_rcpf(e.b.y), __builtin_amdgcn_rcpf(e.b.z), __builtin_amdgcn_rcpf(e.b.w)};
                    const f8 eg = mul8(gc, ie);
                    *(LAS u32x4*)(CHP(cq, C_KT) + tl * 72 + jo * 8) = pack8(mul8(kk8, ep));
                    *(LAS u32x4*)(CHP(cq, C_RT) + tl * 72 + jo * 8) = pack8(mul8(r8, e));
                    *(LAS u32x4*)(CHP(cq, C_BT) + tl * 72 + jo * 8) = pack8(mul8(bb8, ie));
                    *(LAS u32x4*)(CHP(cq, C_KK) + tl * 72 + jo * 8) = pack8(mul8(kp8, ie));
                    const u32x4 pk = pack8(mul8(kp8, eg)), pb = pack8(mul8(bb8, eg));
                    LAS bf16* kg = CHP(cq, C_KG) + (jo * 8) * 24 + tl; LAS bf16* bg = CHP(cq, C_BG) + (jo * 8) * 24 + tl;
                    kg[0 * 24] = (bf16)(pk.x & 0xffffu); kg[1 * 24] = (bf16)(pk.x >> 16); kg[2 * 24] = (bf16)(pk.y & 0xffffu); kg[3 * 24] = (bf16)(pk.y >> 16);
                    kg[4 * 24] = (bf16)(pk.z & 0xffffu); kg[5 * 24] = (bf16)(pk.z >> 16); kg[6 * 24] = (bf16)(pk.w & 0xffffu); kg[7 * 24] = (bf16)(pk.w >> 16);
                    bg[0 * 24] = (bf16)(pb.x & 0xffffu); bg[1 * 24] = (bf16)(pb.x >> 16); bg[2 * 24] = (bf16)(pb.y & 0xffffu); bg[3 * 24] = (bf16)(pb.y >> 16);
                    bg[4 * 24] = (bf16)(pb.z & 0xffffu); bg[5 * 24] = (bf16)(pb.z >> 16); bg[6 * 24] = (bf16)(pb.w & 0xffffu); bg[7 * 24] = (bf16)(pb.w >> 16); }
                BARRIER();
                if (wave < 4) { const int q = wave;
                    f32x4 mkb = z4, mkk = z4, mbr = z4, mkr = z4;
#pragma unroll
                    for (int ks = 0; ks < 2; ++ks) { const int o = li * 72 + ks * 32 + lq * 8;
                        const pg8::bf16x8 xb = *(const LAS pg8::bf16x8*)(CHP(q, C_BT) + o), xk = *(const LAS pg8::bf16x8*)(CHP(q, C_KK) + o), yk = *(const LAS pg8::bf16x8*)(CHP(q, C_KT) + o), yr = *(const LAS pg8::bf16x8*)(CHP(q, C_RT) + o);
                        mkb = __builtin_amdgcn_mfma_f32_16x16x32_bf16(xb, yk, mkb, 0, 0, 0); mkk = __builtin_amdgcn_mfma_f32_16x16x32_bf16(xk, yk, mkk, 0, 0, 0);
                        mbr = __builtin_amdgcn_mfma_f32_16x16x32_bf16(xb, yr, mbr, 0, 0, 0); mkr = __builtin_amdgcn_mfma_f32_16x16x32_bf16(xk, yr, mkr, 0, 0, 0); }
                    const int t = li, j0 = 4 * lq;
                    const f32x4 ms = (f32x4){j0 < t ? 1.f : 0.f, j0 + 1 < t ? 1.f : 0.f, j0 + 2 < t ? 1.f : 0.f, j0 + 3 < t ? 1.f : 0.f};
                    const f32x4 me = (f32x4){j0 <= t ? 1.f : 0.f, j0 + 1 <= t ? 1.f : 0.f, j0 + 2 <= t ? 1.f : 0.f, j0 + 3 <= t ? 1.f : 0.f};
                    mkb = mkb * ms; mkk = mkk * ms; mbr = mbr * me; mkr = mkr * me;
                    u32x2 w; w.x = pk2(mkk.x, mkk.y); w.y = pk2(mkk.z, mkk.w); *(LAS u32x2*)(CHP(q, C_AKK) + t * 24 + j0) = w;
                    w.x = pk2(mbr.x, mbr.y); w.y = pk2(mbr.z, mbr.w); *(LAS u32x2*)(CHP(q, C_BBR) + t * 24 + j0) = w;
                    w.x = pk2(mkr.x, mkr.y); w.y = pk2(mkr.z, mkr.w); *(LAS u32x2*)(CHP(q, C_BKR) + t * 24 + j0) = w;
                    {   typedef short bf16x4 __attribute__((ext_vector_type(4)));
                        LAS bf16* BR = CHP(q, C_AKB);
                        f32x4 Bn = -mkb;
                        f32x4 Pn = Bn + (f32x4){j0 == t ? 1.f : 0.f, j0 + 1 == t ? 1.f : 0.f, j0 + 2 == t ? 1.f : 0.f, j0 + 3 == t ? 1.f : 0.f};
#pragma unroll
                        for (int n = 0; n < 3; ++n) {
                            { const unsigned w0 = pk2(Bn.x, Bn.y), w1 = pk2(Bn.z, Bn.w); LAS bf16* p = BR + j0 * 24 + t;
                              p[0] = (bf16)(w0 & 0xffffu); p[24] = (bf16)(w0 >> 16); p[48] = (bf16)(w1 & 0xffffu); p[72] = (bf16)(w1 >> 16); }
                            asm volatile("s_waitcnt lgkmcnt(0)" ::: "memory");
                            const bf16x4 brow = *(const LAS bf16x4*)(BR + li * 24 + 4 * lq);
                            u32x2 cb; cb.x = pk2(Bn.x, Bn.y); cb.y = pk2(Bn.z, Bn.w);
                            const f32x4 Bsq = __builtin_amdgcn_mfma_f32_16x16x16bf16_1k(brow, __builtin_bit_cast(bf16x4, cb), z4, 0, 0, 0);
                            asm volatile("s_waitcnt lgkmcnt(0)" ::: "memory");
                            { const unsigned w0 = pk2(Bsq.x, Bsq.y), w1 = pk2(Bsq.z, Bsq.w); LAS bf16* p = BR + j0 * 24 + t;
                              p[0] = (bf16)(w0 & 0xffffu); p[24] = (bf16)(w0 >> 16); p[48] = (bf16)(w1 & 0xffffu); p[72] = (bf16)(w1 >> 16); }
                            asm volatile("s_waitcnt lgkmcnt(0)" ::: "memory");
                            const bf16x4 b1row = *(const LAS bf16x4*)(BR + li * 24 + 4 * lq);
                            u32x2 cp; cp.x = pk2(Pn.x, Pn.y); cp.y = pk2(Pn.z, Pn.w);
                            Pn = __builtin_amdgcn_mfma_f32_16x16x16bf16_1k(b1row, __builtin_bit_cast(bf16x4, cp), Pn, 0, 0, 0);
                            asm volatile("s_waitcnt lgkmcnt(0)" ::: "memory");
                            Bn = Bsq;
                        }
                        w.x = pk2(Pn.x, Pn.y); w.y = pk2(Pn.z, Pn.w); *(LAS u32x2*)(CHP(q, C_TT) + t * 24 + j0) = w;
                    }
                }
                BARRIER();
                if (wave >= 4) { const int v0 = (wave - 4) * 16;
#define F4(q, off, row, stride, col) (*(const LAS bf16x4*)(CHP(q, off) + (row) * (stride) + (col)))
#define CVT4(A_) ({ const f32x4 t_ = (A_); u32x2 w_; w_.x = pk2(t_.x, t_.y); w_.y = pk2(t_.z, t_.w); __builtin_bit_cast(bf16x4, w_); })
#define MF16(a, b, c) __builtin_amdgcn_mfma_f32_16x16x16bf16_1k(a, b, c, 0, 0, 0)
                    for (int q = 0; q < 4; ++q) {
                        const bf16x4 s0 = CVT4(S0), s1 = CVT4(S1), s2 = CVT4(S2), s3 = CVT4(S3);
                        const bf16x4 vf = F4(q, C_VT, v0 + li, 24, 4 * lq);
                        f32x4 aw = z4;
                        aw = MF16(F4(q, C_KT, li, 72, 0 + 4 * lq), s0, aw); aw = MF16(F4(q, C_KT, li, 72, 16 + 4 * lq), s1, aw);
                        aw = MF16(F4(q, C_KT, li, 72, 32 + 4 * lq), s2, aw); aw = MF16(F4(q, C_KT, li, 72, 48 + 4 * lq), s3, aw);
                        aw = MF16(F4(q, C_AKK, li, 24, 4 * lq), vf, aw);
                        f32x4 au = MF16(F4(q, C_TT, li, 24, 4 * lq), CVT4(aw), z4);
                        au = -au; const bf16x4 nu = CVT4(au);
                        f32x4 ay = z4;
                        ay = MF16(F4(q, C_RT, li, 72, 0 + 4 * lq), s0, ay); ay = MF16(F4(q, C_RT, li, 72, 16 + 4 * lq), s1, ay);
                        ay = MF16(F4(q, C_RT, li, 72, 32 + 4 * lq), s2, ay); ay = MF16(F4(q, C_RT, li, 72, 48 + 4 * lq), s3, ay);
                        ay = MF16(F4(q, C_BKR, li, 24, 4 * lq), vf, ay); ay = MF16(F4(q, C_BBR, li, 24, 4 * lq), nu, ay);
                        { LAS float* yp = YR + (q * 16 + 4 * lq) * 68 + v0 + li; yp[0] = ay.x; yp[68] = ay.y; yp[136] = ay.z; yp[204] = ay.w; }
                        const LAS float* gcp = GCx + q * 64 + 4 * lq;
                        S0 = S0 * *(const LAS f32x4*)(gcp); S1 = S1 * *(const LAS f32x4*)(gcp + 16); S2 = S2 * *(const LAS f32x4*)(gcp + 32); S3 = S3 * *(const LAS f32x4*)(gcp + 48);
                        S0 = MF16(F4(q, C_KG, 0 + li, 24, 4 * lq), vf, S0); S0 = MF16(F4(q, C_BG, 0 + li, 24, 4 * lq), nu, S0);
                        S1 = MF16(F4(q, C_KG, 16 + li, 24, 4 * lq), vf, S1); S1 = MF16(F4(q, C_BG, 16 + li, 24, 4 * lq), nu, S1);
                        S2 = MF16(F4(q, C_KG, 32 + li, 24, 4 * lq), vf, S2); S2 = MF16(F4(q, C_BG, 32 + li, 24, 4 * lq), nu, S2);
                        S3 = MF16(F4(q, C_KG, 48 + li, 24, 4 * lq), vf, S3); S3 = MF16(F4(q, C_BG, 48 + li, 24, 4 * lq), nu, S3);
                    }
#undef F4
#undef CVT4
#undef MF16
                }
                BARRIER();
                {   f8 y = ld8lds(YR + tt * 68 + jo * 8);
                    const float mean = red8(hsum8(y)) * (1.0f / 64.0f); y.a = y.a - mean; y.b = y.b - mean;
                    const float var = red8(hsum8(mul8(y, y))) * (1.0f / 64.0f); const float rstd = 1.0f / sqrtf(var + GN_EPS);
                    const f8 gw = ld8lds(cs2 + 384 + jo * 8), gb = ld8lds(cs2 + 448 + jo * 8), gt8 = unpack8(gate_raw);
                    f8 o; o.a = (y.a * rstd * gw.a + gb.a + v8.a * rk) * gt8.a; o.b = (y.b * rstd * gw.b + gb.b + v8.b * rk) * gt8.b;
                    *(u32x4*)(Y + (size_t)(m0 + tt) * D + cofs) = pack8(o); }
            }
            if (wave >= 4) { float* o = ap->out + O_WKVP + (((size_t)l * NB + b) * NH + h) * 4096 + (size_t)((wave - 4) * 16 + li) * 64 + 4 * lq;
                stnt4(o, S0); stnt4(o + 16, S1); stnt4(o + 32, S2); stnt4(o + 48, S3); }
        }
#undef CHP
#undef BARRIER
    }
    {
        LAS float* wv = (LAS float*)(lds + 112640 + wave * 1536);
        for (int it = bid * NWAVES + wave; it < DECB * NH; it += G * NWAVES) {
            const int i = it >> 4, h = it & 15, m = MP + i; float rk;
            { const int c = h * 64 + lane; const bf16* p = PROJ + (size_t)m * INC + c; const bf16* q = p + (size_t)DECB * INC;
              const float mr = mu[C_R + c], mk = mu[C_K + c], mv = mu[C_V + c];
              const float r = bf1(p[C_R]), k = bf1(p[C_K]), v = bf1(p[C_V]); (void)q; (void)mr; (void)mk; (void)mv;
              const float w = __expf(-0.60653065971f * sigm(bf1(LO[(size_t)m * 3072 + c]))); const float av = sigm(bf1(LO[(size_t)m * 3072 + 1024 + c]));
              float kk = k * ap->in[I_KK][l * D + c]; const float ss = wave_sum(kk * kk); kk *= 1.0f / fmaxf(sqrtf(ss), 1e-12f);
              const float kp = k * (1.0f + (av - 1.0f) * ap->in[I_KA][l * D + c]); const float bb = kk * av;
              rk = wave_sum(r * kp * ap->in[I_RK][l * D + c]);
              asm volatile("s_waitcnt lgkmcnt(0)" ::: "memory");
              wv[lane] = kk; wv[64 + lane] = w; wv[128 + lane] = bb; wv[192 + lane] = kp; wv[256 + lane] = r; wv[320 + lane] = v; }
            asm volatile("s_waitcnt lgkmcnt(0)" ::: "memory");
            const int kq = lane & 7, r0 = lane >> 3;
            const f8 kk = ld8lds(wv + kq * 8), w = ld8lds(wv + 64 + kq * 8), bb = ld8lds(wv + 128 + kq * 8), k8 = ld8lds(wv + 192 + kq * 8), r8 = ld8lds(wv + 256 + kq * 8);
            const size_t so = (((size_t)l * DECB + i) * NH + h) * 4096 + (size_t)r0 * 64 + kq * 8;
            const float* sp = ap->in[I_SWKV] + so; float* op = ap->out + O_WKVS + so;
            f8 st[8]; float yv[8];
#pragma unroll
            for (int j = 0; j < 8; ++j) { st[j].a = ldnt4(sp + j * 512); st[j].b = ldnt4(sp + j * 512 + 4); }
#pragma unroll
            for (int j = 0; j < 8; ++j) {
                const float v = wv[320 + r0 + 8 * j];
                f8 s = st[j];
                const float sa = red8(hsum8(mul8(s, kk)));
                s.a = s.a * w.a + (k8.a * v - bb.a * sa); s.b = s.b * w.b + (k8.b * v - bb.b * sa);
                yv[j] = red8(hsum8(mul8(s, r8)));
                stnt4(op + j * 512, s.a); stnt4(op + j * 512 + 4, s.b);
            }
            float ys = 0.f;
#pragma unroll
            for (int j = 0; j < 8; ++j) ys += yv[j];
            const float mean = wave_sum(ys) * (1.0f / 512.0f); float q2 = 0.f;
#pragma unroll
            for (int j = 0; j < 8; ++j) { yv[j] -= mean; q2 += yv[j] * yv[j]; }
            const float rstd = 1.0f / sqrtf(wave_sum(q2) * (1.0f / 512.0f) + GN_EPS);
            if (kq == 0) {
#pragma unroll
                for (int j = 0; j < 8; ++j) { const int row = r0 + 8 * j, c = h * 64 + row;
                    const float o = (yv[j] * rstd * ap->in[I_GNW][l * D + c] + ap->in[I_GNB][l * D + c] + rk * wv[320 + row]) * bf1(LO[(size_t)m * 3072 + 2048 + c]);
                    Y[(size_t)m * D + c] = (bf16)(pk2(o, 0.f) & 0xffffu); } }
        }
    }
}

__device__ __forceinline__ void phase_post(KArgs ap, int l, int gt, int NGT) {
    unsigned char* ws = ap->ws; const bf16* PROJ = (const bf16*)(ws + WS_PROJ); const bf16* LO = (const bf16*)(ws + WS_LO); bf16* Y = (bf16*)(ws + WS_Y); const float* RK = (const float*)(ws + WS_RK);
    const float* muv = ap->in[I_MU] + (size_t)l * 3328 + C_V; const float* gnw = ap->in[I_GNW] + l * D; const float* gnb = ap->in[I_GNB] + l * D;
    for (int idx = MP * 128 + gt; idx < MT * 128; idx += NGT) {
        const int m = idx >> 7, c0 = (idx & 127) * 8, h = c0 >> 6;
        f8 y = ld8b(Y + (size_t)m * D + c0);
        const float mean = red8(hsum8(y)) * (1.0f / 64.0f); y.a = y.a - mean; y.b = y.b - mean;
        const float var = red8(hsum8(mul8(y, y))) * (1.0f / 64.0f); const float rstd = 1.0f / sqrtf(var + GN_EPS);
        const f8 cur = ld8b(PROJ + (size_t)m * INC + C_V + c0); const int pr = prev_row(m);
        const f8 prev = pr >= 0 ? ld8b(PROJ + (size_t)pr * INC + C_V + c0) : zero8();
        const f8 v = mix8(cur, prev, ld8f(muv + c0));
        const float rk = RK[(size_t)m * 16 + h]; const f8 g = ld8b(LO + (size_t)m * 3072 + 2048 + c0); const f8 gw = ld8f(gnw + c0), gb = ld8f(gnb + c0);
        f8 o; o.a = (y.a * rstd * gw.a + gb.a + v.a * rk) * g.a; o.b = (y.b * rstd * gw.b + gb.b + v.b * rk) * g.b;
        *(u32x4*)(Y + (size_t)m * D + c0) = pack8(o);
    }
}

__device__ __forceinline__ f8 conv8(f8 u0, f8 u1, f8 u2, const float* cw, const float* cb, int c) {
    const f8 w0 = ld8f(cw + c), w1 = ld8f(cw + FF2 + c), w2 = ld8f(cw + 2 * FF2 + c), bb = ld8f(cb + c); f8 r;
    r.a = bb.a + u0.a * w0.a + u1.a * w1.a + u2.a * w2.a; r.b = bb.b + u0.b * w0.b + u1.b * w1.b + u2.b * w2.b; return r;
}
__device__ __forceinline__ int up_col(int c) { return c < DFF ? (c / 128) * 256 + (c % 128) : ((c - DFF) / 128) * 256 + 128 + ((c - DFF) % 128); }
__device__ __forceinline__ void phase_conv(KArgs ap, int l, int gt, int NGT) {
    unsigned char* ws = ap->ws; const bf16* U = (const bf16*)(ws + WS_U); bf16* ACT = (bf16*)(ws + WS_ACT);
    const float* cw = ap->in[I_CW] + (size_t)l * 3 * FF2; const float* cb = ap->in[I_CB] + (size_t)l * FF2; const float* sconv = ap->in[I_SCONV] + (size_t)l * DECB * 2 * FF2;
    for (int idx = gt; idx < (MP / 64) * 704; idx += NGT) {
        const int blk = idx / 704, rem = idx % 704, m = blk * 64 + rem / 352, f0 = (rem % 352) * 8, t = m & (SEQ - 1);
        const bf16* up = U + (size_t)m * FF2 + up_col(f0);
        const f8 v2 = ld8b(up), g2 = ld8b(up + 128); f8 v1 = zero8(), g1 = v1, v0 = v1, g0 = v1;
        if (t >= 1) { v1 = ld8b(up - FF2); g1 = ld8b(up - FF2 + 128); }
        if (t >= 2) { v0 = ld8b(up - 2 * FF2); g0 = ld8b(up - 2 * FF2 + 128); }
        const f8 val = conv8(v0, v1, v2, cw, cb, f0), gate = conv8(g0, g1, g2, cw, cb, f0 + DFF);
        const f8 sg = sigm8(gate); f8 o; o.a = val.a * gate.a * sg.a; o.b = val.b * gate.b * sg.b;
        *(u32x4*)(ACT + (size_t)m * DFF + f0) = pack8(o);
    }
    for (int idx = gt; idx < DECB * 352; idx += NGT) {
        const int m = MP + idx / 352, f0 = (idx % 352) * 8;
        const bf16* up = U + (size_t)m * FF2 + up_col(f0);
        const f8 v2 = ld8b(up), g2 = ld8b(up + 128);
        const float* sp = sconv + (size_t)(m - MP) * 2 * FF2 + f0; const f8 v0 = ld8f(sp), g0 = ld8f(sp + DFF), v1 = ld8f(sp + FF2), g1 = ld8f(sp + FF2 + DFF);
        const f8 val = conv8(v0, v1, v2, cw, cb, f0), gate = conv8(g0, g1, g2, cw, cb, f0 + DFF);
        const f8 sg = sigm8(gate); f8 o; o.a = val.a * gate.a * sg.a; o.b = val.b * gate.b * sg.b;
        *(u32x4*)(ACT + (size_t)m * DFF + f0) = pack8(o);
    }
    for (int idx = gt; idx < NB * 2 * 704; idx += NGT) { const int c = (idx % 704) * 8, i = (idx / 704) & 1, b = idx / 1408;
        const f8 v = ld8b(U + (size_t)(b * SEQ + SEQ - 2 + i) * FF2 + up_col(c)); float* o = ap->out + O_CONVP + (((size_t)l * NB + b) * 2 + i) * FF2 + c; stnt4(o, v.a); stnt4(o + 4, v.b); }
    for (int idx = gt; idx < DECB * 2 * 704; idx += NGT) { const int c = (idx % 704) * 8, i = (idx / 704) & 1, b = idx / 1408;
        const f8 v = (i == 0) ? ld8f(sconv + ((size_t)b * 2 + 1) * FF2 + c) : ld8b(U + (size_t)(MP + b) * FF2 + up_col(c));
        float* o = ap->out + O_CONVS + (((size_t)l * DECB + b) * 2 + i) * FF2 + c; stnt4(o, v.a); stnt4(o + 4, v.b); }
}

__device__ __forceinline__ void skinny_part(const bf16* A, const bf16* Bt, int K, int row0, int col0, int wave, int lane, f32x4& acc0, f32x4& acc1) {
    const int i = lane & 15, q = lane >> 4, ks = K >> 3, kbeg = wave * ks;
    const bf16* pa0 = A + (size_t)(row0 + i) * K + kbeg + 8 * q; const bf16* pa1 = pa0 + (size_t)16 * K; const bf16* pb = Bt + (size_t)(col0 + i) * K + kbeg + 8 * q;
    for (int k = 0; k < ks; k += 32) { const pg8::bf16x8 b = *(const pg8::bf16x8*)(pb + k), a0 = *(const pg8::bf16x8*)(pa0 + k), a1 = *(const pg8::bf16x8*)(pa1 + k);
        acc0 = __builtin_amdgcn_mfma_f32_16x16x32_bf16(b, a0, acc0, 0, 0, 0); acc1 = __builtin_amdgcn_mfma_f32_16x16x32_bf16(b, a1, acc1, 0, 0, 0); }
}
__device__ __forceinline__ f32x4 skinny_sum(const LAS float* red, int t) { f32x4 s = *(const LAS f32x4*)(red + t * 4);
#pragma unroll
    for (int w = 1; w < 8; ++w) s += *(const LAS f32x4*)(red + (w * 128 + t) * 4);
    return s; }
template <int MODE> __device__ __forceinline__ void skinny_phase(KArgs ap, int l, int jmod, const bf16* A1, const bf16* W1, int K1, const bf16* A2, const bf16* W2, int K2,
                                                                  LAS unsigned char* lds, int tid, int lane, int wave, int bid, int G) {
    unsigned char* ws = ap->ws; LAS float* red1 = (LAS float*)lds; LAS float* red2 = (LAS float*)(lds + 16384);
    for (int u = bid; u < 256; u += G) {
        const int row0 = MP + (u & 3) * 32, col0 = (u >> 2) * 16; const f32x4 z = (f32x4){0.f, 0.f, 0.f, 0.f};
        f32x4 a0 = z, a1 = z, c0 = z, c1 = z;
        skinny_part(A1, W1, K1, row0, col0, wave, lane, a0, a1);
        if (MODE == 0) skinny_part(A2, W2, K2, row0, col0, wave, lane, c0, c1);
        __syncthreads();
        *(LAS f32x4*)(red1 + ((wave * 2 + 0) * 64 + lane) * 4) = a0; *(LAS f32x4*)(red1 + ((wave * 2 + 1) * 64 + lane) * 4) = a1;
        if (MODE == 0) { *(LAS f32x4*)(red2 + ((wave * 2 + 0) * 64 + lane) * 4) = c0; *(LAS f32x4*)(red2 + ((wave * 2 + 1) * 64 + lane) * 4) = c1; }
        __syncthreads();
        if (tid < 128) { const int rt = tid >> 6, ln = tid & 63, row = row0 + 16 * rt + (ln & 15), col = col0 + 4 * (ln >> 4);
            const f32x4 s1 = skinny_sum(red1, tid);
            if (MODE == 0) { const f32x4 s2 = skinny_sum(red2, tid); const bf16* pj = (const bf16*)(ws + WS_PROJ) + (size_t)row * INC + col;
                const f32x4 o = sigm4(ld4b(pj + C_GP)) * s1 + sigm4(ld4b(pj + C_GR)) * s2; u32x2 w; w.x = pk2(o.x, o.y); w.y = pk2(o.z, o.w);
                *(u32x2*)((bf16*)(ws + WS_MG) + (size_t)row * D + col) = w; }
            else { bf16* xp = (bf16*)(ws + WS_XB) + (size_t)row * D + col; const f32x4 g = *(const f32x4*)((const float*)(ws + WS_MOD) + (size_t)cidx_of(row) * NMOD2 + l * NMOD + jmod * D + col);
                const f32x4 r = ld4b(xp) * ALPHA + (g + 1.0f) * s1; u32x2 w; w.x = pk2(r.x, r.y); w.y = pk2(r.z, r.w); *(u32x2*)xp = w; } }
    }
    __syncthreads();
}

#define XB_TMO      128
#define XB_XCNT(j)  (256  + 64 * (j))
#define XB_XSUB(j)  (1280 + 64 * (j))
#define XB_XGEN(j)  (2304 + 64 * (j))
#define XB_TOP      3328
#define XB_TOPGEN   3392
#define XCD_BAR_WORDS 3456
#define XB_SPIN_CAP (1u << 18)

__device__ __forceinline__ unsigned xb_ld(unsigned* p)              { return __hip_atomic_load(p, __ATOMIC_RELAXED, __HIP_MEMORY_SCOPE_AGENT); }
__device__ __forceinline__ unsigned xb_add(unsigned* p, unsigned v) { return __hip_atomic_fetch_add(p, v, __ATOMIC_RELAXED, __HIP_MEMORY_SCOPE_AGENT); }
__device__ __forceinline__ unsigned xb_xcc_id() { return (unsigned)__builtin_amdgcn_s_getreg((3 << 11) | 20) & 0xFu; }
#define XB_SPIN(cond, bar) do { unsigned _sp = 0; while (cond) { __builtin_amdgcn_s_sleep(1); \
    if ((++_sp & 255u) == 0u) { if (xb_ld(&(bar)[XB_TMO])) break; if (_sp > XB_SPIN_CAP) { atomicAdd(&(bar)[XB_TMO], 1u); break; } } } } while (0)

struct XcdBarrier {
    unsigned* bar; unsigned x;
    volatile LAS unsigned* st;
};

__device__ __forceinline__ XcdBarrier xcd_barrier_post(unsigned* bar, volatile LAS unsigned* st) {
    XcdBarrier b; b.bar = bar; b.x = xb_xcc_id(); b.st = st;
    if (threadIdx.x == 0) (void)xb_add(&bar[XB_XCNT(b.x)], 1u);
    return b;
}
__device__ __forceinline__ void xcd_barrier_complete(unsigned* bar, unsigned x, unsigned& nloc, unsigned& nx) {
    const unsigned G = gridDim.x * gridDim.y * gridDim.z;
    unsigned sum, cnt, mine, sp = 0u;
    for (;;) {
        sum = 0u; cnt = 0u; mine = 0u;
#pragma unroll
        for (unsigned j = 0; j < 16; ++j) { const unsigned c = xb_ld(&bar[XB_XCNT(j)]); sum += c; cnt += (c > 0u) ? 1u : 0u; mine = (j == x) ? c : mine; }
        if (sum == G) break;
        __builtin_amdgcn_s_sleep(1);
        if ((++sp & 255u) == 0u) { if (xb_ld(&bar[XB_TMO])) break; if (sp > XB_SPIN_CAP) { atomicAdd(&bar[XB_TMO], 1u); break; } }
    }
    nloc = mine > 0u ? mine : 1u; nx = cnt > 0u ? cnt : 1u;
}

__device__ __forceinline__ void xcd_barrier(const XcdBarrier& b) {
    asm volatile("s_waitcnt vmcnt(0)" ::: "memory");
    __syncthreads();
    if (threadIdx.x == 0) {
        unsigned* bar = b.bar;
        __builtin_amdgcn_s_waitcnt(0);
        unsigned nloc = b.st[0], nx = b.st[1];
        if (nloc == 0u) { xcd_barrier_complete(bar, b.x, nloc, nx); b.st[0] = nloc; b.st[1] = nx; }
        const unsigned old = xb_add(&bar[XB_XSUB(b.x)], 1u);
        const unsigned gen = old / nloc;
        if (old + 1u == (gen + 1u) * nloc) {
            __builtin_amdgcn_fence(__ATOMIC_RELEASE, "agent");
            asm volatile("s_waitcnt vmcnt(0)" ::: "memory");
            const unsigned og = xb_add(&bar[XB_TOP], 1u);
            const unsigned tg = og / nx;
            if (og + 1u == (tg + 1u) * nx) xb_add(&bar[XB_TOPGEN], 1u);
            else XB_SPIN(xb_ld(&bar[XB_TOPGEN]) == tg, bar);
            __builtin_amdgcn_fence(__ATOMIC_ACQUIRE, "agent");
            xb_add(&bar[XB_XGEN(b.x)], 1u);
            asm volatile("s_waitcnt vmcnt(0)" ::: "memory");
        } else {
            XB_SPIN(xb_ld(&bar[XB_XGEN(b.x)]) == gen, bar);
            __builtin_amdgcn_fence(__ATOMIC_ACQUIRE, "agent");
            asm volatile("s_waitcnt vmcnt(0)" ::: "memory");
        }
    }
    __syncthreads();
}

#ifndef MK_MULTI
#define MK_MULTI 0
#endif
constexpr int PH_PER_LAYER = 12, N_PHASES = 2 + NL * PH_PER_LAYER + 1;

__device__ __forceinline__ int static_unit_pm(int M, int N, int G, int c, int i) {
    const int nM = M / 256, nN = N / 256, nwg = nM * nN; const long L = (long)i * G + c; if (L >= nwg) return -1;
    int wgid = (int)L; { const int q = nwg / 8, r = nwg % 8, xcd = wgid % 8, off = wgid / 8; wgid = (xcd < r ? xcd * (q + 1) : r * (q + 1) + (xcd - r) * q) + off; }
    const int nig = 8 * nN, gid = wgid / nig, fm = gid * 8, gsz = (nM - fm) < 8 ? (nM - fm) : 8;
    return fm + ((wgid % nig) % gsz);
}
__device__ __forceinline__ int static_unit_pmpn(int M, int N, int G, int c, int i) {
    const int nM = M / 256, nN = N / 256, nwg = nM * nN; const long L = (long)i * G + c; if (L >= nwg) return -1;
    int wgid = (int)L; { const int q = nwg / 8, r = nwg % 8, xcd = wgid % 8, off = wgid / 8; wgid = (xcd < r ? xcd * (q + 1) : r * (q + 1) + (xcd - r) * q) + off; }
    const int nig = 8 * nN, gid = wgid / nig, fm = gid * 8, gsz = (nM - fm) < 8 ? (nM - fm) : 8;
    return ((fm + ((wgid % nig) % gsz)) << 4) | ((wgid % nig) / gsz);
}
__device__ __forceinline__ unsigned* seam_ctr(unsigned char* ws, int l, int s, int id) { return (unsigned*)(ws + WS_CTL) + 16384 + ((l * 3 + s) * 80 + id) * 16; }
__device__ __forceinline__ void seam_arrive2(unsigned* c1, unsigned* c2) {
    asm volatile("s_waitcnt vmcnt(0)" ::: "memory"); __syncthreads();
    if (threadIdx.x == 0) { __builtin_amdgcn_fence(__ATOMIC_RELEASE, "agent"); asm volatile("s_waitcnt vmcnt(0)" ::: "memory");
        (void)__hip_atomic_fetch_add(c1, 1u, __ATOMIC_RELAXED, __HIP_MEMORY_SCOPE_AGENT); (void)__hip_atomic_fetch_add(c2, 1u, __ATOMIC_RELAXED, __HIP_MEMORY_SCOPE_AGENT); }
}
__device__ __forceinline__ void seam_wait(unsigned* c, unsigned n) {
    if (threadIdx.x == 0) { unsigned sp = 0; while (__hip_atomic_load(c, __ATOMIC_RELAXED, __HIP_MEMORY_SCOPE_AGENT) < n) { __builtin_amdgcn_s_sleep(1); if (++sp > (1u << 22)) break; }
        __builtin_amdgcn_fence(__ATOMIC_ACQUIRE, "agent"); asm volatile("s_waitcnt vmcnt(0)" ::: "memory"); }
    __syncthreads();
}
__device__ __forceinline__ void al_fixup_panel(KArgs ap, int l, int pm, int tid) {
    unsigned char* ws = ap->ws; const bf16* PJ = (const bf16*)(ws + WS_PROJ); const bf16* R63 = (const bf16*)(ws + WS_R63); bf16* AL = (bf16*)(ws + WS_AL); const float* mua = ap->in[I_MU] + (size_t)l * 3328 + C_WL;
    if (pm >= MP / 256 || tid >= 128) return;
    const int m = pm * 256 + (tid >> 5) * 64, j0 = (tid & 31) * 8; const f8 cur = ld8b(PJ + (size_t)m * INC + C_WL + j0);
    f8 prev = zero8(); if (m & (SEQ - 1)) prev = ld8b(R63 + (size_t)((m >> 6) - 1) * 3328 + C_WL + j0);
    f8 xs = mix8(cur, prev, ld8f(mua + j0));
    if (j0 < 64) { xs = sigm8(scl8(xs, 2.0f)); xs.a = xs.a * 2.0f - 1.0f; xs.b = xs.b * 2.0f - 1.0f; }
    else if (j0 >= 128) xs = sigm8(xs);
    *(u32x4*)(AL + (size_t)m * 256 + j0) = pack8(xs);
}
__device__ __forceinline__ void subset_barrier(unsigned* ctr, unsigned n) {
    asm volatile("s_waitcnt vmcnt(0)" ::: "memory"); __syncthreads();
    if (threadIdx.x == 0) {
        __builtin_amdgcn_fence(__ATOMIC_RELEASE, "agent"); asm volatile("s_waitcnt vmcnt(0)" ::: "memory");
        (void)__hip_atomic_fetch_add(ctr, 1u, __ATOMIC_RELAXED, __HIP_MEMORY_SCOPE_AGENT);
        unsigned sp = 0; while (__hip_atomic_load(ctr, __ATOMIC_RELAXED, __HIP_MEMORY_SCOPE_AGENT) < n) { __builtin_amdgcn_s_sleep(2); if (++sp > (1u << 22)) break; }
        __builtin_amdgcn_fence(__ATOMIC_ACQUIRE, "agent"); asm volatile("s_waitcnt vmcnt(0)" ::: "memory");
    }
    __syncthreads();
}
template <class Epi> __device__ __forceinline__ void run_gemm(LAS unsigned char* lds, const bf16* A, const bf16* Bt, int M, int N, int K, int G, int bid, const Epi& E) {
    pg8::Gemm g{A, Bt, M, N, K}; pg8::StaticOrder S; S.init(M, N, G, bid);
    pg8::gemm_phase<Epi, pg8::StaticOrder, true, true>((PG8_LAS unsigned char*)lds, g, S, E);
}

__global__ void __launch_bounds__(NTHR, 2) mega_fwd(Args a_unused) {
    extern __shared__ __attribute__((aligned(16))) unsigned char lds_raw[];
    LAS unsigned char* lds = (LAS unsigned char*)lds_raw;
    const int bid = blockIdx.x, G = gridDim.x;
#define TIDS const int tid = opqv((int)threadIdx.x), lane = tid & 63, wave = __builtin_amdgcn_readfirstlane(tid >> 6); (void)lane; (void)wave;
    int lo, hi; XcdBarrier bar;
    { KArgs ap0 = fresh_args(); lo = ap0->ph_lo; hi = ap0->ph_hi;
      volatile LAS unsigned* misc = (volatile LAS unsigned*)(lds + MISC_OFF);
      if (threadIdx.x < 4) misc[threadIdx.x] = 0u;
      __syncthreads();
      bar = xcd_barrier_post((unsigned*)(ap0->ws + WS_CTL), misc); }
#ifndef EN_MASK
#define EN_MASK 0xffffffffu
#endif
#define EN(x) ((EN_MASK >> (x)) & 1u)
#ifndef REP_MASK
#define REP_MASK 0u
#endif
#define REPS(x) for (int rp_ = 0; rp_ <= (int)((REP_MASK >> (x)) & 1u); ++rp_)
#define IN(k) (lo <= (k) && (k) < hi)
#define SEAM(k) do { if (IN(k) && IN((k) + 1)) { xcd_barrier(bar); } } while (0)
#define WSP(T, off) ((T*)(ws + (off)))
    REPS(0) if (EN(0) && IN(0)) { TIDS phase_prep(fresh_args(), lds, tid, lane, wave, opq(bid), opq(G), 0); }
    SEAM(0);
    REPS(1) if (EN(1) && IN(1)) { KArgs ap = fresh_args(); unsigned char* ws = ap->ws; EpiF32Bias E{WSP(float, WS_MOD), NMOD2, ap->in[I_ADAB]};
        pg8::Gemm g{WSP(const bf16, WS_CALL), WSP(const bf16, WS_ADA), 256, NMOD2, D}; pg8::StaticOrder S; S.init(256, NMOD2, opq(G), opq(bid));
        pg8::gemm_phase<EpiF32Bias, pg8::StaticOrder, true, true>((PG8_LAS unsigned char*)lds, g, S, E);
        constexpr int NADA = NMOD2 / 256;
        if (G > NADA) { if (bid >= NADA) { TIDS phase_prep(fresh_args(), lds, tid, lane, wave, opq(bid) - NADA, opq(G) - NADA, 2); } }
        else { __syncthreads(); TIDS phase_prep(fresh_args(), lds, tid, lane, wave, opq(bid), opq(G), 2); }
        { unsigned* c = seam_ctr(ws, 0, 0, 70); if (bid < NADA) seam_arrive2(c, seam_ctr(ws, 0, 0, 71)); seam_wait(c, (unsigned)NADA); } }
#pragma nounroll
    for (int l = 0; l < NL; ++l) {
        const int P = 2 + l * PH_PER_LAYER;
        if (l == 0) {
        REPS(2) if (EN(2) && IN(P + 0)) { TIDS const int gw_ = opq(bid) * NWAVES + wave, ngw_ = opq(G) * NWAVES; phase_rowpass(fresh_args(), 0, l, lane, gw_, ngw_, gw_, ngw_, MT, true); }
        SEAM(P + 0); }
        REPS(3) if (EN(3) && IN(P + 1)) { KArgs ap = fresh_args(); unsigned char* ws = ap->ws;
            EpiProj E{WSP(bf16, WS_PROJ), WSP(bf16, WS_AL), WSP(bf16, WS_R63), ap->in[I_MU] + (size_t)l * 3328}; run_gemm(lds, WSP(const bf16, WS_H), WSP(const bf16, WS_WIN + l * SZ_WIN), MPAD, INC, D, opq(G), opq(bid), E); }
        SEAM(P + 1);
        REPS(5) if (EN(5) && IN(P + 3)) {
            { TIDS KArgs apf = fresh_args(); const int Gq = opq(G), cq_ = opq(bid); for (int i = 0; ; ++i) { const int pm_ = static_unit_pm(MPAD, 3072, Gq, cq_, i); if (pm_ < 0) break; al_fixup_panel(apf, l, pm_, tid); }
              asm volatile("s_waitcnt vmcnt(0)" ::: "memory"); __syncthreads(); }
            { KArgs ap = fresh_args(); unsigned char* ws = ap->ws; pg8::EpiBf16<0> E{WSP(bf16, WS_LO), 3072, WSP(const float, WS_LBIAS) + l * 3072, 0, 0, 1.f};
              run_gemm(lds, WSP(const bf16, WS_AL), WSP(const bf16, WS_LORA + l * SZ_LORA), MPAD, 3072, 256, opq(G), opq(bid), E); }
 }
        SEAM(P + 3);
        REPS(6) if (EN(6) && IN(P + 4)) {
            if (G > NB * NH && bid >= NB * NH) {
                { TIDS phase_prepC(fresh_args(), l, (opq(bid) - NB * NH) * NTHR + tid, (opq(G) - NB * NH) * NTHR); }
                KArgs ap = fresh_args(); unsigned char* ws = ap->ws;
                subset_barrier((unsigned*)(ap->ws + WS_CTL) + 8192 + 64 * l + 32, (unsigned)(G - NB * NH));
                pg8::EpiBf16<0> E{WSP(bf16, WS_PM), 512, nullptr, 0, 0, 1.f};
                run_gemm(lds, WSP(const bf16, WS_PD), WSP(const bf16, WS_PW + l * SZ_PW), MPAD, 512, 512, opq(G) - NB * NH, opq(bid) - NB * NH, E);
                __syncthreads();
                subset_barrier((unsigned*)(ap->ws + WS_CTL) + 8192 + 64 * l, (unsigned)(G - NB * NH));
                { KArgs ap2 = fresh_args(); unsigned char* ws = ap2->ws; EpiGate E2{WSP(const bf16, WS_PROJ) + C_GP, INC, WSP(bf16, WS_MG), D, 0};
                  run_gemm(lds, WSP(const bf16, WS_PM), WSP(const bf16, WS_WBP + l * SZ_WBP), MP, D, 512, opq(G) - NB * NH, opq(bid) - NB * NH, E2); }
                __syncthreads();
                { TIDS phase_prep(fresh_args(), lds, tid, lane, wave, opq(bid) - NB * NH, opq(G) - NB * NH, l == 0 ? 1 : 3); __syncthreads(); } }
            else if (G <= NB * NH) {
                KArgs ap = fresh_args(); unsigned char* ws = ap->ws; pg8::EpiBf16<0> E{WSP(bf16, WS_PM), 512, nullptr, 0, 0, 1.f};
                run_gemm(lds, WSP(const bf16, WS_PD), WSP(const bf16, WS_PW + l * SZ_PW), MPAD, 512, 512, opq(G), opq(bid), E);
                __syncthreads(); }
            { TIDS phase_scan(fresh_args(), l, lds, tid, lane, wave, opq(bid), opq(G)); } }
        SEAM(P + 4);
        REPS(8) if (EN(8) && IN(P + 6)) {

            { KArgs ap = fresh_args(); unsigned char* ws = ap->ws; EpiGate E{WSP(const bf16, WS_PROJ) + C_GR, INC, WSP(bf16, WS_MG), D, 1};
              run_gemm(lds, WSP(const bf16, WS_Y), WSP(const bf16, WS_WBR + l * SZ_WBR), MP, D, D, opq(G), opq(bid), E); }
            { TIDS KArgs ap = fresh_args(); unsigned char* ws = ap->ws; skinny_phase<0>(ap, l, 0, WSP(const bf16, WS_PM), WSP(const bf16, WS_WBP + l * SZ_WBP), 512, WSP(const bf16, WS_Y), WSP(const bf16, WS_WBR + l * SZ_WBR), D, lds, tid, lane, wave, opq(bid), opq(G)); }
            { KArgs ap = fresh_args(); unsigned char* ws = ap->ws; const int pp = static_unit_pmpn(MP, D, opq(G), opq(bid), 0);
              seam_arrive2(seam_ctr(ws, l, 2, pp >> 4), seam_ctr(ws, l, 2, 64 + (bid & 3))); seam_wait(seam_ctr(ws, l, 2, pp >> 4), 4u); } }
        REPS(9) if (EN(9) && IN(P + 7)) { KArgs ap = fresh_args(); unsigned char* ws = ap->ws; EpiRes E{WSP(bf16, WS_XB), WSP(const float, WS_MOD) + l * NMOD + 2 * D};
            run_gemm(lds, WSP(const bf16, WS_MG), WSP(const bf16, WS_WOUT + l * SZ_WOUT), MP, D, D, opq(G), opq(bid), E);
            seam_wait(seam_ctr(ws, l, 2, 64 + (bid & 3)), 64u);
            { TIDS skinny_phase<1>(ap, l, 2, WSP(const bf16, WS_MG), WSP(const bf16, WS_WOUT + l * SZ_WOUT), D, nullptr, nullptr, 0, lds, tid, lane, wave, opq(bid), opq(G)); }
            { TIDS const int pp = static_unit_pmpn(MP, D, opq(G), opq(bid), 0), pm = pp >> 4, pn = pp & 15, rb = bid & 3;
              seam_arrive2(seam_ctr(ws, l, 0, pm), seam_ctr(ws, l, 0, 64 + rb)); seam_wait(seam_ctr(ws, l, 0, pm), 4u);
              phase_rowpass(ap, 1, l, lane, 0, 1, pm * 256 + pn * 64 + wave, 8, pm * 256 + pn * 64 + 64, false);
              if (bid < 16) { seam_wait(seam_ctr(ws, l, 0, 64 + rb), 64u); const int ms = MP + rb * 32 + (bid >> 2) * 8 + wave; phase_rowpass(ap, 1, l, lane, 0, 1, ms, 8, ms + 1, false); } } }
        SEAM(P + 8);
        REPS(11) if (EN(11) && IN(P + 9)) { KArgs ap = fresh_args(); unsigned char* ws = ap->ws; EpiConv E{WSP(bf16, WS_U), WSP(bf16, WS_ACT), ap->in[I_CW] + (size_t)l * 3 * FF2, ap->in[I_CB] + (size_t)l * FF2};
            run_gemm(lds, WSP(const bf16, WS_H), WSP(const bf16, WS_UP + l * SZ_UP), MPAD, FF2, D, opq(G), opq(bid), E); }
        SEAM(P + 9);
        REPS(12) if (EN(12) && IN(P + 10)) { TIDS phase_conv(fresh_args(), l, opq(bid) * NTHR + tid, opq(G) * NTHR); }
        SEAM(P + 10);
        REPS(13) if (EN(13) && IN(P + 11)) { KArgs ap = fresh_args(); unsigned char* ws = ap->ws; EpiRes E{WSP(bf16, WS_XB), WSP(const float, WS_MOD) + l * NMOD + 5 * D};
            run_gemm(lds, WSP(const bf16, WS_ACT), WSP(const bf16, WS_DOWN + l * SZ_DOWN), MP, D, DFF, opq(G), opq(bid), E);
            { TIDS skinny_phase<1>(ap, l, 5, WSP(const bf16, WS_ACT), WSP(const bf16, WS_DOWN + l * SZ_DOWN), DFF, nullptr, nullptr, 0, lds, tid, lane, wave, opq(bid), opq(G)); }
            { TIDS const int pp = static_unit_pmpn(MP, D, opq(G), opq(bid), 0), pm = pp >> 4, pn = pp & 15, rb = bid & 3, st = (l + 1 < NL) ? 2 : 3;
              phase_rowpass(ap, st, l + 1, lane, opq(bid) * NWAVES + wave, opq(G) * NWAVES, 0, 1, 0, true);
              seam_arrive2(seam_ctr(ws, l, 1, pm), seam_ctr(ws, l, 1, 64 + rb)); seam_wait(seam_ctr(ws, l, 1, pm), 4u);
              phase_rowpass(ap, st, l + 1, lane, 0, 1, pm * 256 + pn * 64 + wave, 8, pm * 256 + pn * 64 + 64, false);
              if (bid < 16) { seam_wait(seam_ctr(ws, l, 1, 64 + rb), 64u); const int ms = MP + rb * 32 + (bid >> 2) * 8 + wave; phase_rowpass(ap, st, l + 1, lane, 0, 1, ms, 8, ms + 1, false); } } }
        if (l + 1 < NL) SEAM(P + 11);
    }
#undef IN
#undef SEAM
}

extern "C" void kernel_launch(void* const* d_in, const int* in_sizes, int n_in, void* d_out, int out_size, void* d_ws, size_t ws_size, hipStream_t stream) {
    static int grid = 0;
    if (grid == 0) {
        if (n_in != N_IN || (size_t)out_size != O_END || ws_size < WS_END) { fprintf(stderr, "kernel_launch: unexpected shapes (n_in %d out %d ws %zu)\n", n_in, out_size, ws_size); grid = -1; return; }
        int dev = 0, cus = 0, per_cu = 0;
        if (hipGetDevice(&dev) != hipSuccess || hipDeviceGetAttribute(&cus, hipDeviceAttributeMultiprocessorCount, dev) != hipSuccess) { grid = -1; return; }
        if (hipFuncSetAttribute((const void*)mega_fwd, hipFuncAttributeMaxDynamicSharedMemorySize, LDS_BYTES) != hipSuccess) { fprintf(stderr, "kernel_launch: hipFuncSetAttribute failed\n"); grid = -1; return; }
        if (hipOccupancyMaxActiveBlocksPerMultiprocessor(&per_cu, (const void*)mega_fwd, NTHR, LDS_BYTES) != hipSuccess || per_cu < 1) { fprintf(stderr, "kernel_launch: occupancy query says %d\n", per_cu); per_cu = 1; }
        (void)hipGetLastError();
        grid = cus * 1;
        if (grid != 256) { fprintf(stderr, "kernel_launch: the counted seams of this schedule need exactly 256 workgroups (one per CU of a 256-CU device), got %d\n", grid); grid = -1; return; }
        if (grid <= NB * NH) { fprintf(stderr, "kernel_launch: this schedule needs more than %d workgroups (CUs), got %d\n", NB * NH, grid); grid = -1; return; }
    }
    if (grid < 0) return;
    if (hipMemsetAsync((char*)d_ws + WS_CTL, 0, CTL_ZERO_BYTES, stream) != hipSuccess) { fprintf(stderr, "kernel_launch: memset failed\n"); return; }
    Args a{};
    for (int i = 0; i < N_IN; ++i) a.in[i] = (const float*)d_in[i];
    a.out = (float*)d_out; a.ws = (unsigned char*)d_ws;
#if MK_MULTI
    for (int p = 0; p < N_PHASES; ++p) { a.ph_lo = p; a.ph_hi = p + 1; hipLaunchKernelGGL(mega_fwd, dim3(grid), dim3(NTHR), LDS_BYTES, stream, a); }
#else
    a.ph_lo = 0; a.ph_hi = N_PHASES;
    void* args[] = {&a};
    hipError_t e = hipLaunchCooperativeKernel((const void*)mega_fwd, dim3(grid), dim3(NTHR), args, LDS_BYTES, stream);
    if (e != hipSuccess) fprintf(stderr, "kernel_launch: cooperative launch failed: %s (grid %d)\n", hipGetErrorString(e), grid);
#endif
}
```

```cpp
#include <hip/hip_runtime.h>
#include <hip/hip_cooperative_groups.h>
#include <cstdio>
#include <cstdint>
namespace cg = cooperative_groups;
namespace pg8 {
#define PG8_LAS __attribute__((address_space(3)))
typedef unsigned short bf16_t;
typedef short bf16x8 __attribute__((ext_vector_type(8)));
typedef float f32x4 __attribute__((ext_vector_type(4)));
typedef unsigned u32x4 __attribute__((ext_vector_type(4)));
constexpr int BM = 256, BK = 64, HALF = 128, HTB = HALF * BK * 2  , STAGE_BYTES = 8 * HTB, NXCD = 8, WGM = 4;

__host__ __device__ __forceinline__ int lds_byte(int r, int c) { const int st = (r >> 4) * 2 + (c >> 5), rr = r & 15, cc = c & 31, ob = rr * 64 + cc * 2; return st * 1024 + (ob ^ (((ob >> 9) & 1) << 5)); }
__host__ __device__ __forceinline__ void stage_rc(int b, int& R, int& C) { const int st = b / 1024, sb = b % 1024, swz = sb ^ (((sb >> 9) & 1) << 5); R = (st >> 1) * 16 + swz / 64; C = (st & 1) * 32 + (swz % 64) / 2; }
__host__ __device__ __forceinline__ int perm32(int rho) { const int n = rho >> 4, i = rho & 15; return 8 * (i >> 2) + 4 * n + (i & 3); }

struct Unit { int pm, pn; };
struct Gemm { const bf16_t* A; const bf16_t* Bt; int M, N, K; };

struct StaticOrder {
    int nM, nN, nwg, G, c;
    __host__ __device__ void init(int M, int N, int G_, int c_) { nM = M / BM; nN = N / BM; nwg = nM * nN; G = G_; c = c_; }
    __host__ __device__ bool next(int i, Unit& u) const {
        const long L = (long)i * G + c; if (L >= nwg) return false;
        int wgid = (int)L; { const int q = nwg / NXCD, r = nwg % NXCD, xcd = wgid % NXCD, off = wgid / NXCD; wgid = (xcd < r ? xcd * (q + 1) : r * (q + 1) + (xcd - r) * q) + off; }
        const int nig = WGM * nN, gid = wgid / nig, fm = gid * WGM, gsz = (nM - fm) < WGM ? (nM - fm) : WGM;
        u.pm = fm + ((wgid % nig) % gsz); u.pn = (wgid % nig) / gsz; return true;
    }
    __device__ __forceinline__ void a_ready(const Unit&) const {}
    __device__ __forceinline__ void done(const Unit&) const {}
};

__device__ __forceinline__ unsigned cvt_pk_bf16(float lo, float hi) { unsigned r; asm volatile("v_cvt_pk_bf16_f32 %0, %1, %2" : "=v"(r) : "v"(lo), "v"(hi)); return r; }
typedef float f32x2 __attribute__((ext_vector_type(2)));
__device__ __forceinline__ f32x2 gelu_pk(f32x2 v) {
    const f32x2 av = __builtin_elementwise_abs(v), d = av * 0.2316418882f + 1.0f;
    f32x2 t; t.x = __builtin_amdgcn_rcpf(d.x); t.y = __builtin_amdgcn_rcpf(d.y);
    f32x2 q = t * 0.5307027145f + (-0.7265760135f); q = q * t + 0.7107068705f; q = q * t + (-0.142248368f); q = q * t + 0.127414796f; q = q * t;
    const f32x2 s = (v * v) * (-0.72134752044f);
    f32x2 e; e.x = __builtin_amdgcn_exp2f(s.x); e.y = __builtin_amdgcn_exp2f(s.y);
    const f32x2 m = v * (q * e), r = v - m;
    f32x2 o; o.x = v.x < 0.f ? m.x : r.x; o.y = v.y < 0.f ? m.y : r.y; return o;
}

template <int ACT  > struct EpiBf16 {
    static constexpr bool PERM = true, AFTER_DRAIN = false; static_assert(ACT == 0 || ACT == 1, "EpiBf16: ACT is 0 (none) or 1 (gelu_pk)");
    bf16_t* O; int ldc; const float* bias; int split_cols; size_t split_stride; float scale0;
    __device__ __forceinline__ void operator()(const f32x4 (&acc)[2][2][4][2], const Unit& u, int wr, int wc, int fr, int fq) const {
        const int row0 = u.pm * BM + wr * 64 + fr; int colt = u.pn * BM; bf16_t* base = O;
        float sc = 1.f; if (split_cols) { const int t = colt / split_cols; base += (size_t)t * split_stride; colt -= t * split_cols; if (t == 0) sc = scale0; }
        const int col0 = colt + wc * 32 + 8 * fq, bcol0 = u.pn * BM + wc * 32 + 8 * fq;
        f32x4 bv[2][2];
#pragma unroll
        for (int bj = 0; bj < 2; ++bj)
#pragma unroll
            for (int n = 0; n < 2; ++n) bv[bj][n] = bias ? *(const f32x4*)(bias + bcol0 + bj * HALF + 4 * n) : (f32x4){0.f, 0.f, 0.f, 0.f};
#pragma unroll
        for (int ai = 0; ai < 2; ++ai)
#pragma unroll
            for (int m = 0; m < 4; ++m) { bf16_t* rowp = base + (size_t)(row0 + ai * HALF + m * 16) * ldc + col0;
#pragma unroll
                for (int bj = 0; bj < 2; ++bj) { f32x4 v0 = acc[ai][bj][m][0] + bv[bj][0], v1 = acc[ai][bj][m][1] + bv[bj][1];
                    if (ACT == 1) { f32x2 a = gelu_pk((f32x2){v0[0], v0[1]}), b = gelu_pk((f32x2){v0[2], v0[3]}), c = gelu_pk((f32x2){v1[0], v1[1]}), d = gelu_pk((f32x2){v1[2], v1[3]});
                        v0 = (f32x4){a.x, a.y, b.x, b.y}; v1 = (f32x4){c.x, c.y, d.x, d.y}; }
                    v0 = v0 * sc; v1 = v1 * sc; u32x4 w; w.x = cvt_pk_bf16(v0[0], v0[1]); w.y = cvt_pk_bf16(v0[2], v0[3]); w.z = cvt_pk_bf16(v1[0], v1[1]); w.w = cvt_pk_bf16(v1[2], v1[3]);
                    *(u32x4*)(rowp + bj * HALF) = w; } }
    }
};

struct PanelStats {
    unsigned* xbuf;
    unsigned* cnt;
    unsigned* tmo;
    int ntn; float eps;
    unsigned code;
    __device__ __forceinline__ bool run(const f32x4 (&v)[2][2][4][2], const Unit& u, int wr, int wc, int fr, int fq, PG8_LAS unsigned char* lds, int wid, int lane) const {
        typedef float f32x2v __attribute__((ext_vector_type(2)));
        PG8_LAS f32x2v* P = (PG8_LAS f32x2v*)lds;
        PG8_LAS f32x2v* S = (PG8_LAS f32x2v*)(lds + 8192);
        PG8_LAS unsigned* flag = (PG8_LAS unsigned*)(lds + 8192 + 2048);
#pragma unroll
        for (int ai = 0; ai < 2; ++ai)
#pragma unroll
            for (int m = 0; m < 4; ++m) {
                float s = 0.f;
#pragma unroll
                for (int bj = 0; bj < 2; ++bj)
#pragma unroll
                    for (int n = 0; n < 2; ++n) { const f32x4 x = v[ai][bj][m][n]; s += (x[0] + x[1]) + (x[2] + x[3]); }
                s += __shfl_xor(s, 16); s += __shfl_xor(s, 32);
                const float mw = s * (1.0f / 64.0f); float q = 0.f;
#pragma unroll
                for (int bj = 0; bj < 2; ++bj)
#pragma unroll
                    for (int n = 0; n < 2; ++n) { const f32x4 d = v[ai][bj][m][n] - mw; q += (d[0] * d[0] + d[1] * d[1]) + (d[2] * d[2] + d[3] * d[3]); }
                q += __shfl_xor(q, 16); q += __shfl_xor(q, 32);
                if (fq == 0) P[(ai * HALF + wr * 64 + m * 16 + fr) * 4 + wc] = (f32x2v){mw, q};
            }
        asm volatile("s_waitcnt lgkmcnt(0)" ::: "memory"); __builtin_amdgcn_s_barrier(); asm volatile("" ::: "memory");
#if defined(BROKEN_EXCHANGE_NO_WAIT)
#warning BROKEN CONTROL BUILD: the row-statistics exchange does not wait; results are wrong by design
        if (blockIdx.x >= 64) { const long long t0_ = clock64(); while (clock64() - t0_ < 60000) __builtin_amdgcn_s_sleep(8); }
#endif
        const int row = wid * 32 + (lane & 31);
        if (lane < 32) {
            const f32x2v a = P[row * 4 + 0], b = P[row * 4 + 1], c = P[row * 4 + 2], d = P[row * 4 + 3];
            const float mt = (a.x + b.x + c.x + d.x) * 0.25f;
            const float da = a.x - mt, db = b.x - mt, dc = c.x - mt, dd = d.x - mt;
            const float m2 = (a.y + b.y) + (c.y + d.y) + 64.0f * ((da * da + db * db) + (dc * dc + dd * dd));
            unsigned long long* slot = (unsigned long long*)xbuf + ((size_t)(u.pm * BM + row) * 4 + u.pn);
            __hip_atomic_store(slot, ((unsigned long long)__float_as_uint(m2) << 32) | __float_as_uint(mt), __ATOMIC_RELAXED, __HIP_MEMORY_SCOPE_AGENT);
        }
        asm volatile("s_waitcnt vmcnt(0)" ::: "memory");
        if (lane == 0) __hip_atomic_fetch_add(cnt + 64 * u.pm, 1u, __ATOMIC_RELAXED, __HIP_MEMORY_SCOPE_AGENT);
        if (wid == 0) {
            bool dead = false; const unsigned long long t0 = __builtin_amdgcn_s_memrealtime(); const unsigned want = 8u * (unsigned)ntn;
            for (;;) {
#if defined(BROKEN_EXCHANGE_NO_WAIT)
                break;
#endif
                if ((unsigned)__builtin_amdgcn_readfirstlane(__hip_atomic_load(cnt + 64 * u.pm, __ATOMIC_RELAXED, __HIP_MEMORY_SCOPE_AGENT)) >= want) break;
                if (__builtin_amdgcn_s_memrealtime() - t0 > 2000000ull) {
                    if (lane == 0) { unsigned expect = 0u; __hip_atomic_compare_exchange_strong(tmo + 1, &expect, code | (unsigned)(u.pm & 0xff), __ATOMIC_RELAXED, __ATOMIC_RELAXED, __HIP_MEMORY_SCOPE_AGENT);
                                     __hip_atomic_store(tmo, 1u, __ATOMIC_RELAXED, __HIP_MEMORY_SCOPE_AGENT); }
                    dead = true; break; }
                __builtin_amdgcn_s_sleep(2);
            }
            __builtin_amdgcn_fence(__ATOMIC_ACQUIRE, "agent");
            if (lane == 0) flag[0] = dead ? 1u : 0u;
        }
        asm volatile("s_waitcnt vmcnt(0) lgkmcnt(0)" ::: "memory"); __builtin_amdgcn_s_barrier(); asm volatile("" ::: "memory");
        const bool bad = flag[0] != 0u;
        if (lane < 32) {
            const unsigned long long* slot = (const unsigned long long*)xbuf + (size_t)(u.pm * BM + row) * 4; float mt[4], m2[4]; float ms = 0.f;
#pragma unroll
            for (int t = 0; t < 4; ++t) { if (t < ntn) { const unsigned long long w = __hip_atomic_load(slot + t, __ATOMIC_RELAXED, __HIP_MEMORY_SCOPE_AGENT); mt[t] = __uint_as_float((unsigned)w); m2[t] = __uint_as_float((unsigned)(w >> 32)); } else { mt[t] = 0.f; m2[t] = 0.f; } ms += mt[t]; }
            const float mean = ms / (float)ntn; float q = 0.f;
#pragma unroll
            for (int t = 0; t < 4; ++t) if (t < ntn) { const float dm = mt[t] - mean; q += m2[t] + 256.0f * dm * dm; }
            S[row] = (f32x2v){mean, 1.0f / sqrtf(q / (256.0f * (float)ntn) + eps)};
        }
        asm volatile("s_waitcnt lgkmcnt(0)" ::: "memory"); __builtin_amdgcn_s_barrier(); asm volatile("" ::: "memory");
        return bad;
    }
};
struct EpiLnRes {
    static constexpr bool PERM = false, AFTER_DRAIN = true;
    const float* base; float* out; int ldc; const float* bias; PanelStats st; unsigned poison;
    __device__ __forceinline__ void fused(f32x4 (&acc)[2][2][4][2], const Unit& u, int wr, int wc, int fr, int fq, PG8_LAS unsigned char* lds, int wid, int lane) const {
        typedef float f32x2v __attribute__((ext_vector_type(2)));
        const PG8_LAS f32x2v* S = (const PG8_LAS f32x2v*)(lds + 8192);
        const int col0 = u.pn * BM + wc * 32 + 4 * fq;
#pragma unroll
        for (int bj = 0; bj < 2; ++bj)
#pragma unroll
            for (int n = 0; n < 2; ++n) { const f32x4 bv = bias ? *(const f32x4*)(bias + col0 + bj * HALF + n * 16) : (f32x4){0.f, 0.f, 0.f, 0.f};
#pragma unroll
                for (int ai = 0; ai < 2; ++ai)
#pragma unroll
                    for (int m = 0; m < 4; ++m) acc[ai][bj][m][n] += bv; }
        f32x4 pre[4][2][2];
#pragma unroll
        for (int m = 0; m < 4; ++m) { const size_t off = (size_t)(u.pm * BM + wr * 64 + m * 16 + fr) * ldc + col0;
#pragma unroll
            for (int bj = 0; bj < 2; ++bj)
#pragma unroll
                for (int n = 0; n < 2; ++n) pre[m][bj][n] = *(const f32x4*)(base + off + bj * HALF + n * 16); }
        const bool bad = st.run(acc, u, wr, wc, fr, fq, lds, wid, lane) || poison != 0u;
        const float qnan = __builtin_nanf("");
#pragma unroll
        for (int ai = 0; ai < 2; ++ai)
#pragma unroll
            for (int m = 0; m < 4; ++m) { const int r = ai * HALF + wr * 64 + m * 16 + fr; const f32x2v sr = S[r]; const size_t off = (size_t)(u.pm * BM + r) * ldc + col0;
#pragma unroll
                for (int bj = 0; bj < 2; ++bj)
#pragma unroll
                    for (int n = 0; n < 2; ++n) { const f32x4 bs = ai == 0 ? pre[m][bj][n] : *(const f32x4*)(base + off + bj * HALF + n * 16); f32x4 o = bs + (acc[ai][bj][m][n] - sr.x) * sr.y;
                        if (bad) o = (f32x4){qnan, qnan, qnan, qnan}; *(f32x4*)(out + off + bj * HALF + n * 16) = o; }
                if (m & 1) asm volatile("" ::: "memory"); }
    }
};
struct EpiLnResLn {
    static constexpr bool PERM = false, AFTER_DRAIN = true;
    const float* base; float* out; bf16_t* xn; int ldc; const float* bias; PanelStats st1, st2; unsigned poison;
    __device__ __forceinline__ void fused(f32x4 (&acc)[2][2][4][2], const Unit& u, int wr, int wc, int fr, int fq, PG8_LAS unsigned char* lds, int wid, int lane) const {
        typedef float f32x2v __attribute__((ext_vector_type(2))); typedef unsigned u32x2v __attribute__((ext_vector_type(2)));
        const PG8_LAS f32x2v* S = (const PG8_LAS f32x2v*)(lds + 8192);
        const int col0 = u.pn * BM + wc * 32 + 4 * fq;
#pragma unroll
        for (int bj = 0; bj < 2; ++bj)
#pragma unroll
            for (int n = 0; n < 2; ++n) { const f32x4 bv = bias ? *(const f32x4*)(bias + col0 + bj * HALF + n * 16) : (f32x4){0.f, 0.f, 0.f, 0.f};
#pragma unroll
                for (int ai = 0; ai < 2; ++ai)
#pragma unroll
                    for (int m = 0; m < 4; ++m) acc[ai][bj][m][n] += bv; }
        bool bad = st1.run(acc, u, wr, wc, fr, fq, lds, wid, lane) || poison != 0u;
        const float qnan = __builtin_nanf("");
#pragma unroll
        for (int ai = 0; ai < 2; ++ai)
#pragma unroll
            for (int m = 0; m < 4; ++m) { const int r = ai * HALF + wr * 64 + m * 16 + fr; const f32x2v sr = S[r]; const size_t off = (size_t)(u.pm * BM + r) * ldc + col0;
#pragma unroll
                for (int bj = 0; bj < 2; ++bj)
#pragma unroll
                    for (int n = 0; n < 2; ++n) { const f32x4 bs = *(const f32x4*)(base + off + bj * HALF + n * 16); acc[ai][bj][m][n] = bs + (acc[ai][bj][m][n] - sr.x) * sr.y; }
                asm volatile("" : "+v"(acc[ai][0][m][0]), "+v"(acc[ai][0][m][1]), "+v"(acc[ai][1][m][0]), "+v"(acc[ai][1][m][1]));
                if (m & 1) asm volatile("" ::: "memory"); }
        const bool bad1 = bad;
        bad = st2.run(acc, u, wr, wc, fr, fq, lds, wid, lane) || bad;
#pragma unroll
        for (int ai = 0; ai < 2; ++ai)
#pragma unroll
            for (int m = 0; m < 4; ++m) { const int r = ai * HALF + wr * 64 + m * 16 + fr; const f32x2v sr = S[r]; const size_t off = (size_t)(u.pm * BM + r) * ldc + col0;
#pragma unroll
                for (int bj = 0; bj < 2; ++bj)
#pragma unroll
                    for (int n = 0; n < 2; ++n) { const f32x4 x1 = acc[ai][bj][m][n]; *(f32x4*)(out + off + bj * HALF + n * 16) = bad1 ? (f32x4){qnan, qnan, qnan, qnan} : x1;
                        const f32x4 o = (x1 - sr.x) * sr.y; u32x2v w; w.x = cvt_pk_bf16(o[0], o[1]); w.y = cvt_pk_bf16(o[2], o[3]);
                        if (bad) { w.x = 0x7fc07fc0u; w.y = 0x7fc07fc0u; } *(u32x2v*)(xn + off + bj * HALF + n * 16) = w; }
                asm volatile("" ::: "memory"); }
    }
};

template <class Epi, class Sched, bool ALIGN_EPI = false, bool SP2 = false>
__device__ __forceinline__ void gemm_phase(PG8_LAS unsigned char* lds, const Gemm g, const Sched& S, const Epi& E) {
    int tid_ = threadIdx.x; asm volatile("" : "+v"(tid_));
    const int tid = tid_, wid = __builtin_amdgcn_readfirstlane(tid >> 6), lane = tid & 63, wr = wid >> 2, wc = wid & 3, fr = lane & 15, fq = lane >> 4;
    const int K = g.K, nt = K / BK;
    unsigned voffA[2], voffB[2];
#pragma unroll
    for (int i = 0; i < 2; ++i) { int R, C; stage_rc(tid * 16 + i * 8192, R, C); const int Rb = Epi::PERM ? ((R & ~31) + perm32(R & 31)) : R;
        voffA[i] = (unsigned)(R * K + C) * 2u; voffB[i] = (unsigned)(Rb * K + C) * 2u; }
    const size_t kstep = (size_t)(BK * 2);
    const size_t hstep = (size_t)HALF * K * 2;
    const size_t tstep = 2 * hstep;
    const unsigned ldsw = (unsigned)wid * 1024u;
    const int aoff = lds_byte(wr * 64 + fr, fq * 8), boff = lds_byte(wc * 32 + fr, fq * 8);
#define PG8_SA(b, h) (((b) * 2 + (h)) * HTB)
#define PG8_SB(b, h) ((4 + (b) * 2 + (h)) * HTB)
#define PG8_STAGE(bufoff, gbase, voff) do { _Pragma("unroll") for (int _i = 0; _i < 2; ++_i) \
        __builtin_amdgcn_global_load_lds((const unsigned*)((const char*)(gbase) + (voff)[_i]), (PG8_LAS unsigned*)(lds + (bufoff) + ldsw + _i * 8192), 16, 0, 0); } while (0)
#define PG8_LDA(dst, b, h) do { _Pragma("unroll") for (int m = 0; m < 4; ++m) _Pragma("unroll") for (int k = 0; k < 2; ++k) dst[m][k] = *(const PG8_LAS bf16x8*)(lds + PG8_SA(b, h) + aoff + m * 2048 + k * 1024); } while (0)
#define PG8_LDB(dst, b, h) do { _Pragma("unroll") for (int n = 0; n < 2; ++n) _Pragma("unroll") for (int k = 0; k < 2; ++k) dst[n][k] = *(const PG8_LAS bf16x8*)(lds + PG8_SB(b, h) + boff + n * 2048 + k * 1024); } while (0)
#define PG8_MMA(ai, bj, At, Bt) do { __builtin_amdgcn_s_setprio(1); _Pragma("unroll") for (int m = 0; m < 4; ++m) _Pragma("unroll") for (int n = 0; n < 2; ++n) _Pragma("unroll") for (int k = 0; k < 2; ++k) \
        acc[ai][bj][m][n] = __builtin_amdgcn_mfma_f32_16x16x32_bf16(Bt[n][k], At[m][k], acc[ai][bj][m][n], 0, 0, 0); __builtin_amdgcn_s_setprio(0); } while (0)
#define PG8_WAIT_V(n) asm volatile("s_waitcnt vmcnt(" #n ")" ::: "memory")
#define PG8_WAIT_L(n) asm volatile("s_waitcnt lgkmcnt(" #n ")" ::: "memory")
#define PG8_BAR __builtin_amdgcn_s_barrier()
#define PG8_SCHED __builtin_amdgcn_sched_barrier(0)
    Unit cur, nxt; int ui = 0;
    if (!S.next(0, cur)) return;
    f32x4 acc[2][2][4][2];
#pragma unroll
    for (int a = 0; a < 2; ++a)
#pragma unroll
        for (int b = 0; b < 2; ++b)
#pragma unroll
            for (int m = 0; m < 4; ++m)
#pragma unroll
                for (int n = 0; n < 2; ++n) acc[a][b][m][n] = (f32x4){0.f, 0.f, 0.f, 0.f};
    bf16x8 At[4][2], B0[2][2], B1[2][2];
    const char* cA = (const char*)g.A + (size_t)cur.pm * tstep; const char* cB = (const char*)g.Bt + (size_t)cur.pn * tstep;
    S.a_ready(cur);
    if constexpr (SP2) {
        PG8_STAGE(PG8_SB(0, 0), cB, voffB); PG8_STAGE(PG8_SB(0, 1), cB + hstep, voffB); PG8_STAGE(PG8_SA(0, 0), cA, voffA); PG8_STAGE(PG8_SA(0, 1), cA + hstep, voffA);
        if (wr == 1) PG8_BAR;
        PG8_WAIT_V(2); PG8_BAR;
        PG8_STAGE(PG8_SB(1, 0), cB + kstep, voffB); PG8_STAGE(PG8_SA(1, 0), cA + kstep, voffA); PG8_STAGE(PG8_SB(1, 1), cB + hstep + kstep, voffB);
        PG8_WAIT_V(6); PG8_BAR;
    } else {
        PG8_STAGE(PG8_SB(0, 0), cB, voffB); PG8_STAGE(PG8_SA(0, 0), cA, voffA); PG8_STAGE(PG8_SB(0, 1), cB + hstep, voffB); PG8_STAGE(PG8_SA(0, 1), cA + hstep, voffA);
        if (wr == 1) PG8_BAR;
        PG8_WAIT_V(4); PG8_BAR;
        PG8_STAGE(PG8_SB(1, 0), cB + kstep, voffB); PG8_STAGE(PG8_SA(1, 0), cA + kstep, voffA); PG8_STAGE(PG8_SB(1, 1), cB + hstep + kstep, voffB);
        PG8_WAIT_V(6); PG8_BAR;
    }
    for (;;) {
        const bool has_next = S.next(ui + 1, nxt);
        const char* nA = has_next ? (const char*)g.A + (size_t)nxt.pm * tstep : cA; const char* nB = has_next ? (const char*)g.Bt + (size_t)nxt.pn * tstep : cB;
        for (int t = 0; t < nt; t += 2) {
            const bool last = (t == nt - 2);
            const char* a1 = cA + (size_t)(t + 1) * kstep;
            const char* a2 = last ? nA : cA + (size_t)(t + 2) * kstep; const char* b2 = last ? nB : cB + (size_t)(t + 2) * kstep;
            const char* a3 = a2 + kstep; const char* b3 = b2 + kstep;
            if (last && has_next) S.a_ready(nxt);
            if constexpr (SP2) {
            PG8_LDB(B0, 0, 0); PG8_LDB(B1, 0, 1); PG8_SCHED; PG8_LDA(At, 0, 0); PG8_STAGE(PG8_SA(1, 1), a1 + hstep, voffA);
            PG8_WAIT_V(8); PG8_WAIT_L(0); PG8_BAR; PG8_MMA(0, 0, At, B0); PG8_MMA(0, 1, At, B1); PG8_BAR; PG8_SCHED;
            PG8_LDA(At, 0, 1); PG8_STAGE(PG8_SB(0, 0), b2, voffB); PG8_STAGE(PG8_SB(0, 1), b2 + hstep, voffB); PG8_STAGE(PG8_SA(0, 0), a2, voffA);
            PG8_WAIT_V(8); PG8_WAIT_L(0); PG8_BAR; PG8_MMA(1, 0, At, B0); PG8_MMA(1, 1, At, B1); PG8_BAR; PG8_SCHED;
            PG8_LDB(B0, 1, 0); PG8_LDB(B1, 1, 1); PG8_SCHED; PG8_LDA(At, 1, 0); PG8_STAGE(PG8_SA(0, 1), a2 + hstep, voffA);
            PG8_WAIT_V(8); PG8_WAIT_L(0); PG8_BAR; PG8_MMA(0, 0, At, B0); PG8_MMA(0, 1, At, B1); PG8_BAR; PG8_SCHED;
            PG8_LDA(At, 1, 1); PG8_STAGE(PG8_SB(1, 0), b3, voffB); PG8_STAGE(PG8_SB(1, 1), b3 + hstep, voffB); PG8_STAGE(PG8_SA(1, 0), a3, voffA);
            PG8_WAIT_V(8); PG8_WAIT_L(0); PG8_BAR; PG8_MMA(1, 0, At, B0); PG8_MMA(1, 1, At, B1); PG8_BAR; PG8_SCHED;
            } else {
            PG8_LDB(B0, 0, 0); PG8_SCHED; PG8_LDA(At, 0, 0); PG8_STAGE(PG8_SA(1, 1), a1 + hstep, voffA);
            PG8_WAIT_L(8); PG8_BAR; PG8_WAIT_L(0); PG8_MMA(0, 0, At, B0); PG8_BAR; PG8_SCHED;
            PG8_LDB(B1, 0, 1); PG8_STAGE(PG8_SB(0, 0), b2, voffB);
            PG8_BAR; PG8_WAIT_L(0); PG8_MMA(0, 1, At, B1); PG8_BAR;
            PG8_LDA(At, 0, 1); PG8_STAGE(PG8_SA(0, 0), a2, voffA);
            PG8_BAR; PG8_WAIT_L(0); PG8_MMA(1, 0, At, B0); PG8_BAR; PG8_SCHED;
            PG8_STAGE(PG8_SB(0, 1), b2 + hstep, voffB);
            PG8_WAIT_V(6); PG8_BAR; PG8_MMA(1, 1, At, B1); PG8_BAR;
            PG8_LDB(B0, 1, 0); PG8_SCHED; PG8_LDA(At, 1, 0); PG8_STAGE(PG8_SA(0, 1), a2 + hstep, voffA);
            PG8_WAIT_L(8); PG8_BAR; PG8_WAIT_L(0); PG8_MMA(0, 0, At, B0); PG8_BAR; PG8_SCHED;
            PG8_LDB(B1, 1, 1); PG8_STAGE(PG8_SB(1, 0), b3, voffB);
            PG8_BAR; PG8_WAIT_L(0); PG8_MMA(0, 1, At, B1); PG8_BAR;
            PG8_LDA(At, 1, 1); PG8_STAGE(PG8_SA(1, 0), a3, voffA);
            PG8_BAR; PG8_WAIT_L(0); PG8_MMA(1, 0, At, B0); PG8_BAR; PG8_SCHED;
            PG8_STAGE(PG8_SB(1, 1), b3 + hstep, voffB);
            PG8_WAIT_V(6); PG8_BAR; PG8_MMA(1, 1, At, B1); PG8_BAR;
            }
        }
        if constexpr (ALIGN_EPI) { if (wr == 0) PG8_BAR; }
        if constexpr (!Epi::AFTER_DRAIN) { E(acc, cur, wr, wc, fr, fq); S.done(cur); }
        if (!has_next) break;
#pragma unroll
        for (int a = 0; a < 2; ++a)
#pragma unroll
            for (int b = 0; b < 2; ++b)
#pragma unroll
                for (int m = 0; m < 4; ++m)
#pragma unroll
                    for (int n = 0; n < 2; ++n) acc[a][b][m][n] = (f32x4){0.f, 0.f, 0.f, 0.f};
        cur = nxt; cA = nA; cB = nB; ++ui;
        if constexpr (ALIGN_EPI) { if (wr == 1) PG8_BAR; }
    }
    PG8_WAIT_V(0);
    if constexpr (!ALIGN_EPI) { if (wr == 0) PG8_BAR; }
    PG8_BAR;
    if constexpr (Epi::AFTER_DRAIN) { E.fused(acc, cur, wr, wc, fr, fq, lds, wid, lane); S.done(cur); }
#undef PG8_SA
#undef PG8_SB
#undef PG8_STAGE
#undef PG8_LDA
#undef PG8_LDB
#undef PG8_MMA
#undef PG8_WAIT_V
#undef PG8_WAIT_L
#undef PG8_BAR
#undef PG8_SCHED
}
}
#define LAS __attribute__((address_space(3)))
typedef unsigned short bf16;
typedef float f32x4 __attribute__((ext_vector_type(4)));
typedef unsigned u32x4 __attribute__((ext_vector_type(4)));
typedef unsigned u32x2 __attribute__((ext_vector_type(2)));

constexpr int D = 1024, NB = 8, SEQ = 2048, NL = 2, DECB = 128, NH = 16, HS = 64;
constexpr int DPOOL = 512, PBUF = 15, DFF = 2816, FF2 = 5632, INC = 5888;
constexpr int MP = NB * SEQ, MT = MP + DECB, MPAD = 16640;
constexpr int C_R = 0, C_K = 1024, C_V = 2048, C_WL = 3072, C_POOL = 3328, C_GP = 3840, C_GR = 4864;
constexpr int NMOD = 6 * D, NMOD2 = NL * NMOD;
constexpr float ALPHA = 1.41421356237309515f;
constexpr float LN_EPS = 1e-5f, GN_EPS = 64e-5f;
constexpr int NWAVES = 8, NTHR = 512;

constexpr size_t O_YP = 0, O_YS = 16777216, O_SHP = 16908288, O_WKVP = 16924672, O_POOLP = 17973248, O_CONVP = 18096128,
                 O_SHS = 18276352, O_WKVS = 18538496, O_POOLS = 35315712, O_CONVS = 37281792, O_END = 40165376;

enum { I_XP = 0, I_XS, I_SSHIFT, I_SWKV, I_SPOOL, I_SCONV, I_CP, I_CS, I_ADAW, I_ADAB, I_WIN, I_MU, I_DW0, I_DUP, I_A0, I_AUP, I_GUP,
       I_KK, I_KA, I_RK, I_GNW, I_GNB, I_WBR, I_PW, I_PS, I_WBP, I_WOUT, I_LN1W, I_LN1B, I_UP, I_CW, I_CB, I_DOWN, I_LN2W, I_LN2B, N_IN };

constexpr size_t MiB = 1u << 20;
constexpr size_t SZ_WIN = (size_t)INC * D * 2, SZ_LORA = (size_t)3072 * 256 * 2, SZ_WBR = (size_t)D * D * 2, SZ_PW = (size_t)512 * 512 * 2,
                 SZ_WBP = (size_t)D * 512 * 2, SZ_WOUT = (size_t)D * D * 2, SZ_UP = (size_t)FF2 * D * 2, SZ_DOWN = (size_t)D * DFF * 2;
constexpr size_t WS_WIN = 1 * MiB, WS_LORA = WS_WIN + NL * SZ_WIN, WS_WBR = WS_LORA + NL * SZ_LORA, WS_PW = WS_WBR + NL * SZ_WBR,
                 WS_WBP = WS_PW + NL * SZ_PW, WS_WOUT = WS_WBP + NL * SZ_WBP, WS_UP = WS_WOUT + NL * SZ_WOUT, WS_DOWN = WS_UP + NL * SZ_UP,
                 WS_LBIAS = WS_DOWN + NL * SZ_DOWN, WS_CALL = WS_LBIAS + NL * 3072 * 4, WS_MOD = WS_CALL + 256 * D * 2,
                 WS_RK = WS_MOD + (size_t)256 * NMOD2 * 4, WS_H = WS_RK + (size_t)MPAD * 16 * 4, WS_PROJ = WS_H + (size_t)MPAD * D * 2,
                 WS_AL = WS_PROJ + (size_t)MPAD * INC * 2, WS_PD = WS_AL + (size_t)MPAD * 256 * 2, WS_LO = WS_PD + (size_t)MPAD * 512 * 2,
                 WS_PM = WS_LO + (size_t)MPAD * 3072 * 2, WS_Y = WS_PM + (size_t)MPAD * 512 * 2, WS_XB = WS_Y + (size_t)MPAD * D * 2, WS_R63 = WS_XB + (size_t)MPAD * D * 2, WS_END = WS_R63 + (size_t)(MP / 64) * 3328 * 2;
constexpr size_t WS_ADA = WS_LO, WS_MG = WS_H  , WS_ACT = WS_LO, WS_U = WS_PROJ;
static_assert((size_t)NMOD2 * D * 2 <= (size_t)MPAD * 3072 * 2 && (size_t)MPAD * DFF * 2 <= (size_t)MPAD * 3072 * 2 && (size_t)MPAD * FF2 * 2 <= (size_t)MPAD * INC * 2, "overlays fit");
static_assert(WS_END <= 512 * MiB, "workspace map fits 512 MiB");

constexpr int LDS_BYTES = 147456, MISC_OFF = 140000;
constexpr size_t WS_CTL = 0, CTL_ZERO_BYTES = 131072;

struct Args { const float* in[N_IN]; float* out; unsigned char* ws; int ph_lo, ph_hi; };
typedef const __attribute__((address_space(4))) Args* KArgs;
__device__ __forceinline__ int opqv(int x) { asm volatile("" : "+v"(x)); return x; }
__device__ __forceinline__ int opq(int x) { asm volatile("" : "+s"(x)); return x; }
__device__ __forceinline__ KArgs fresh_args() { KArgs p = (KArgs)__builtin_amdgcn_kernarg_segment_ptr(); asm volatile("" : "+s"(p)); return p; }

__device__ __forceinline__ float bflo(unsigned u) { return __uint_as_float(u << 16); }
__device__ __forceinline__ float bfhi(unsigned u) { return __uint_as_float(u & 0xffff0000u); }
__device__ __forceinline__ float bf1(bf16 b) { return __uint_as_float((unsigned)b << 16); }
typedef float f32x2_t __attribute__((ext_vector_type(2))); typedef __bf16 bf16x2_t __attribute__((ext_vector_type(2)));
__device__ __forceinline__ unsigned pk2(float lo, float hi) { const f32x2_t v = {lo, hi}; const bf16x2_t b = __builtin_convertvector(v, bf16x2_t); return __builtin_bit_cast(unsigned, b); }
struct f8 { f32x4 a, b; };
__device__ __forceinline__ f8 unpack8(u32x4 v) { f8 r; r.a = (f32x4){bflo(v.x), bfhi(v.x), bflo(v.y), bfhi(v.y)}; r.b = (f32x4){bflo(v.z), bfhi(v.z), bflo(v.w), bfhi(v.w)}; return r; }
__device__ __forceinline__ u32x4 pack8(f8 x) { u32x4 r; r.x = pk2(x.a.x, x.a.y); r.y = pk2(x.a.z, x.a.w); r.z = pk2(x.b.x, x.b.y); r.w = pk2(x.b.z, x.b.w); return r; }
__device__ __forceinline__ f32x4 ldnt4(const float* p) { return __builtin_nontemporal_load((const f32x4*)p); }
__device__ __forceinline__ void stnt4(float* p, f32x4 v) { __builtin_nontemporal_store(v, (f32x4*)p); }
__device__ __forceinline__ f8 ld8f(const float* p) { f8 r; r.a = *(const f32x4*)p; r.b = *(const f32x4*)(p + 4); return r; }
__device__ __forceinline__ f8 ld8b(const bf16* p) { return unpack8(*(const u32x4*)p); }
__device__ __forceinline__ f32x4 ld4b(const bf16* p) { const u32x2 v = *(const u32x2*)p; return (f32x4){bflo(v.x), bfhi(v.x), bflo(v.y), bfhi(v.y)}; }
__device__ __forceinline__ f8 zero8() { f8 r; r.a = (f32x4){0.f, 0.f, 0.f, 0.f}; r.b = r.a; return r; }
__device__ __forceinline__ f8 add8(f8 x, f8 y) { f8 r; r.a = x.a + y.a; r.b = x.b + y.b; return r; }
__device__ __forceinline__ f8 sub8(f8 x, f8 y) { f8 r; r.a = x.a - y.a; r.b = x.b - y.b; return r; }
__device__ __forceinline__ f8 mul8(f8 x, f8 y) { f8 r; r.a = x.a * y.a; r.b = x.b * y.b; return r; }
__device__ __forceinline__ f8 scl8(f8 x, float s) { f8 r; r.a = x.a * s; r.b = x.b * s; return r; }
__device__ __forceinline__ f8 mix8(f8 cur, f8 prev, f8 mu) { f8 r; r.a = cur.a + (prev.a - cur.a) * mu.a; r.b = cur.b + (prev.b - cur.b) * mu.b; return r; }
__device__ __forceinline__ float hsum4(f32x4 v) { return (v.x + v.y) + (v.z + v.w); }
__device__ __forceinline__ float hsum8(f8 v) { return hsum4(v.a) + hsum4(v.b); }
__device__ __forceinline__ float sigm(float x) { return __builtin_amdgcn_rcpf(1.0f + __expf(-x)); }
__device__ __forceinline__ f32x4 sigm4(f32x4 v) { return (f32x4){sigm(v.x), sigm(v.y), sigm(v.z), sigm(v.w)}; }
__device__ __forceinline__ f8 sigm8(f8 v) { f8 r; r.a = sigm4(v.a); r.b = sigm4(v.b); return r; }
__device__ __forceinline__ f32x4 exp4(f32x4 v) { return (f32x4){__expf(v.x), __expf(v.y), __expf(v.z), __expf(v.w)}; }
template <int CTRL> __device__ __forceinline__ float dpp_add(float x) { return x + __int_as_float(__builtin_amdgcn_update_dpp(0, __float_as_int(x), CTRL, 0xf, 0xf, true)); }
__device__ __forceinline__ float red8(float x) { x = dpp_add<0xB1>(x); x = dpp_add<0x4E>(x); x = dpp_add<0x141>(x); return x; }
__device__ __forceinline__ float red16(float x) { x = red8(x); x = dpp_add<0x140>(x); return x; }
__device__ __forceinline__ float wave_sum(float v) {
    v = red16(v);
    const float r0 = __int_as_float(__builtin_amdgcn_readlane(__float_as_int(v), 0)), r1 = __int_as_float(__builtin_amdgcn_readlane(__float_as_int(v), 16)),
                r2 = __int_as_float(__builtin_amdgcn_readlane(__float_as_int(v), 32)), r3 = __int_as_float(__builtin_amdgcn_readlane(__float_as_int(v), 48));
    return (r0 + r1) + (r2 + r3);
}
__device__ __forceinline__ int cidx_of(int m) { return m < MP ? (m >> 11) : (NB + (m - MP)); }
__device__ __forceinline__ int prev_row(int m) { return m < MP ? (((m & (SEQ - 1)) > 0) ? m - 1 : -1) : m + DECB; }

struct EpiF32Bias {
    static constexpr bool PERM = false, AFTER_DRAIN = false;
    float* O; int ldc; const float* bias;
    __device__ __forceinline__ void operator()(const pg8::f32x4 (&acc)[2][2][4][2], const pg8::Unit& u, int wr, int wc, int fr, int fq) const {
        const int row0 = u.pm * 256 + wr * 64 + fr, col0 = u.pn * 256 + wc * 32 + 4 * fq;
#pragma unroll
        for (int ai = 0; ai < 2; ++ai)
#pragma unroll
            for (int m = 0; m < 4; ++m) { float* rowp = O + (size_t)(row0 + ai * 128 + m * 16) * ldc + col0;
#pragma unroll
                for (int bj = 0; bj < 2; ++bj)
#pragma unroll
                    for (int n = 0; n < 2; ++n) { const f32x4 bv = *(const f32x4*)(bias + col0 + bj * 128 + n * 16); *(f32x4*)(rowp + bj * 128 + n * 16) = acc[ai][bj][m][n] + bv; } }
    }
};
template <int CTRL> __device__ __forceinline__ float dpp_mov(float x) { return __int_as_float(__builtin_amdgcn_update_dpp(0, __float_as_int(x), CTRL, 0xf, 0xf, true)); }
template <int CTRL> __device__ __forceinline__ f32x4 dpp_mov4(f32x4 v) { return (f32x4){dpp_mov<CTRL>(v.x), dpp_mov<CTRL>(v.y), dpp_mov<CTRL>(v.z), dpp_mov<CTRL>(v.w)}; }
template <int CTRL> __device__ __forceinline__ f32x4 dpp_upd4(f32x4 old, f32x4 v) {
    return (f32x4){__int_as_float(__builtin_amdgcn_update_dpp(__float_as_int(old.x), __float_as_int(v.x), CTRL, 0xf, 0xf, false)), __int_as_float(__builtin_amdgcn_update_dpp(__float_as_int(old.y), __float_as_int(v.y), CTRL, 0xf, 0xf, false)),
                   __int_as_float(__builtin_amdgcn_update_dpp(__float_as_int(old.z), __float_as_int(v.z), CTRL, 0xf, 0xf, false)), __int_as_float(__builtin_amdgcn_update_dpp(__float_as_int(old.w), __float_as_int(v.w), CTRL, 0xf, 0xf, false))};
}
struct EpiConv {
    static constexpr bool PERM = true, AFTER_DRAIN = false;
    bf16* U; bf16* ACT; const float* cw; const float* cb;
    __device__ __forceinline__ void operator()(const pg8::f32x4 (&acc)[2][2][4][2], const pg8::Unit& u, int wr, int wc, int fr, int fq) const {
        const int rowb = u.pm * 256 + wr * 64 + fr, cl = wc * 32 + 8 * fq, f = u.pn * 128 + cl, ucol = u.pn * 256 + cl; const bool tail = (u.pm == MP / 256);
#pragma unroll
        for (int ai = 0; ai < 2; ++ai)
#pragma unroll
            for (int m = 0; m < 4; ++m) { const int row = rowb + ai * 128 + m * 16;
                if (tail ? (row < MT) : ((m == 0 && fr < 2) || (m == 3 && fr >= 14))) { f8 v; v.a = acc[ai][0][m][0]; v.b = acc[ai][0][m][1]; f8 g; g.a = acc[ai][1][m][0]; g.b = acc[ai][1][m][1];
                    bf16* up = U + (size_t)row * FF2 + ucol; *(u32x4*)up = pack8(v); *(u32x4*)(up + 128) = pack8(g); }
                if (!tail) { f8 o;
#pragma unroll
                    for (int n = 0; n < 2; ++n) { const f32x4 v2 = acc[ai][0][m][n], g2 = acc[ai][1][m][n]; f32x4 v1, v0, g1, g0;
                        if (m == 0) { v1 = dpp_mov4<0x111>(v2); v0 = dpp_mov4<0x112>(v2); g1 = dpp_mov4<0x111>(g2); g0 = dpp_mov4<0x112>(g2); }
                        else { const f32x4 pv = acc[ai][0][m > 0 ? m - 1 : 0][n], pg = acc[ai][1][m > 0 ? m - 1 : 0][n];
                            v1 = dpp_upd4<0x111>(dpp_mov4<0x121>(pv), v2); v0 = dpp_upd4<0x112>(dpp_mov4<0x122>(pv), v2);
                            g1 = dpp_upd4<0x111>(dpp_mov4<0x121>(pg), g2); g0 = dpp_upd4<0x112>(dpp_mov4<0x122>(pg), g2); }
                        const float* wp = cw + f + 4 * n; const float* bp = cb + f + 4 * n;
                        const f32x4 cv = *(const f32x4*)bp + v0 * *(const f32x4*)wp + v1 * *(const f32x4*)(wp + FF2) + v2 * *(const f32x4*)(wp + 2 * FF2);
                        const f32x4 cg = *(const f32x4*)(bp + DFF) + g0 * *(const f32x4*)(wp + DFF) + g1 * *(const f32x4*)(wp + FF2 + DFF) + g2 * *(const f32x4*)(wp + 2 * FF2 + DFF);
                        const f32x4 r = cv * cg * sigm4(cg); if (n == 0) o.a = r; else o.b = r; }
                    if (m > 0 || fr >= 2) *(u32x4*)(ACT + (size_t)row * DFF + f) = pack8(o); }
                asm volatile("" ::: "memory"); }
    }
};
struct EpiProj {
    static constexpr bool PERM = true, AFTER_DRAIN = false;
    bf16* PROJ; bf16* AL; bf16* R63; const float* mu;
    __device__ __forceinline__ void operator()(const pg8::f32x4 (&acc)[2][2][4][2], const pg8::Unit& u, int wr, int wc, int fr, int fq) const {
        const int rowb = u.pm * 256 + wr * 64 + fr, cl = wc * 32 + 8 * fq, col0 = u.pn * 256 + cl; const bool tail = (u.pm == MP / 256);
        if (u.pn > 12) {
#pragma unroll
            for (int ai = 0; ai < 2; ++ai)
#pragma unroll
                for (int m = 0; m < 4; ++m)
#pragma unroll
                    for (int bj = 0; bj < 2; ++bj) { f8 v; v.a = acc[ai][bj][m][0]; v.b = acc[ai][bj][m][1]; *(u32x4*)(PROJ + (size_t)(rowb + ai * 128 + m * 16) * INC + col0 + bj * 128) = pack8(v); }
            return; }
#pragma unroll
        for (int bj = 0; bj < 2; ++bj) { const int col = col0 + bj * 128; const f8 m8 = ld8f(mu + col);
#pragma unroll
            for (int ai = 0; ai < 2; ++ai)
#pragma unroll
                for (int m = 0; m < 4; ++m) { const int row = rowb + ai * 128 + m * 16;
                    f8 cur; cur.a = acc[ai][bj][m][0]; cur.b = acc[ai][bj][m][1]; f8 prev; bool raw;
                    if (tail) { prev.a = acc[1][bj][m][0]; prev.b = acc[1][bj][m][1]; raw = false; }
                    else if (m == 0) { prev.a = dpp_mov4<0x111>(cur.a); prev.b = dpp_mov4<0x111>(cur.b); raw = (fr == 0); }
                    else { prev.a = dpp_upd4<0x111>(dpp_mov4<0x121>(acc[ai][bj][m > 0 ? m - 1 : 0][0]), cur.a); prev.b = dpp_upd4<0x111>(dpp_mov4<0x121>(acc[ai][bj][m > 0 ? m - 1 : 0][1]), cur.b); raw = false; }
                    if (tail && ai == 1) continue;
                    if (!tail && m == 3 && fr == 15) *(u32x4*)(R63 + (size_t)(row >> 6) * 3328 + col) = pack8(cur);
                    f8 xs = mix8(cur, prev, m8);
                    if (raw) { *(u32x4*)(PROJ + (size_t)row * INC + col) = pack8(cur); }
                    else if (u.pn < 12) { *(u32x4*)(PROJ + (size_t)row * INC + col) = pack8(xs); }
                    else { if (bj == 0) { if (wc < 2) { xs = sigm8(scl8(xs, 2.0f)); xs.a = xs.a * 2.0f - 1.0f; xs.b = xs.b * 2.0f - 1.0f; } } else xs = sigm8(xs);
                        *(u32x4*)(AL + (size_t)row * 256 + cl + bj * 128) = pack8(xs); }
                    asm volatile("" ::: "memory"); } }
    }
};
struct EpiGate {
    static constexpr bool PERM = true, AFTER_DRAIN = false;
    const bf16* gate; int ldg; bf16* out; int ldo; int accumulate;
    __device__ __forceinline__ void operator()(const pg8::f32x4 (&acc)[2][2][4][2], const pg8::Unit& u, int wr, int wc, int fr, int fq) const {
        const int row0 = u.pm * 256 + wr * 64 + fr, col0 = u.pn * 256 + wc * 32 + 8 * fq;
#pragma unroll
        for (int ai = 0; ai < 2; ++ai)
#pragma unroll
            for (int m = 0; m < 4; ++m) { const int row = row0 + ai * 128 + m * 16;
#pragma unroll
                for (int bj = 0; bj < 2; ++bj) { const int col = col0 + bj * 128;
                    f8 g = sigm8(ld8b(gate + (size_t)row * ldg + col)); f8 v; v.a = acc[ai][bj][m][0] * g.a; v.b = acc[ai][bj][m][1] * g.b;
                    bf16* op = out + (size_t)row * ldo + col;
                    if (accumulate) v = add8(v, ld8b(op));
                    *(u32x4*)op = pack8(v); }
                asm volatile("" ::: "memory"); }
    }
};
struct EpiRes {
    static constexpr bool PERM = true, AFTER_DRAIN = false;
    bf16* X; const float* mod;
    __device__ __forceinline__ void operator()(const pg8::f32x4 (&acc)[2][2][4][2], const pg8::Unit& u, int wr, int wc, int fr, int fq) const {
        const int row0 = u.pm * 256 + wr * 64 + fr, col0 = u.pn * 256 + wc * 32 + 8 * fq;
#pragma unroll
        for (int ai = 0; ai < 2; ++ai)
#pragma unroll
            for (int m = 0; m < 4; ++m) { const int row = row0 + ai * 128 + m * 16;
                if (row < MT) { bf16* xp = X + (size_t)row * D + col0; const float* gp = mod + (size_t)cidx_of(row) * NMOD2 + col0;
#pragma unroll
                    for (int bj = 0; bj < 2; ++bj) { const int o = bj * 128; const f8 x = ld8b(xp + o); const f8 g = ld8f(gp + o);
                        f8 r; r.a = x.a * ALPHA + (g.a + 1.0f) * acc[ai][bj][m][0]; r.b = x.b * ALPHA + (g.b + 1.0f) * acc[ai][bj][m][1];
                        *(u32x4*)(xp + o) = pack8(r); } } }
    }
};

__device__ __forceinline__ void tr_item(const float* W, int ldw, bf16* WT, int ldk, int k0, int n0, const float* rowscale, LAS float* scr, int lane) {
#pragma unroll
    for (int i = 0; i < 8; ++i) { const int kk = 8 * i + (lane >> 3), nq = (lane & 7) * 4;
        const f32x4 v = ldnt4(W + (size_t)(k0 + kk) * ldw + n0 + nq); LAS float* d = scr + kk * 33 + nq; d[0] = v.x; d[1] = v.y; d[2] = v.z; d[3] = v.w; }
    asm volatile("s_waitcnt lgkmcnt(0)" ::: "memory");
    const int c = lane & 7;
#pragma unroll
    for (int j = 0; j < 4; ++j) { const int n = (lane >> 3) + 8 * j; const LAS float* s = scr + (8 * c) * 33 + n; const float sc = rowscale ? rowscale[n0 + n] : 1.0f;
        u32x4 o; o.x = pk2(s[0 * 33] * sc, s[1 * 33] * sc); o.y = pk2(s[2 * 33] * sc, s[3 * 33] * sc); o.z = pk2(s[4 * 33] * sc, s[5 * 33] * sc); o.w = pk2(s[6 * 33] * sc, s[7 * 33] * sc);
        *(u32x4*)(WT + (size_t)(n0 + n) * ldk + k0 + 8 * c) = o; }
    asm volatile("s_waitcnt lgkmcnt(0)" ::: "memory");
}
__device__ __forceinline__ void phase_prep(KArgs ap, LAS unsigned char* lds, int tid, int lane, int wave, int bid, int G, int mode) {
    static_assert(NL == 2, "the weight-conversion schedule is written for two layers");
    unsigned char* ws = ap->ws;
    LAS float* scr = (LAS float*)(lds + wave * 16384);
    const int gw = bid * NWAVES + wave, NGW = G * NWAVES;
    constexpr int PER_L = 2944 + 3072 + 32 + 32 + 64 + 512 + 32 + 256 + 512 + 2816 + 1408;
    constexpr int N_FFN = 2816 + 1408, N_OTH = PER_L - 3072 - N_FFN;
    const int nitems = mode == 0 ? 2 * 3072 : (mode == 1 ? N_OTH : (mode == 3 ? N_FFN : PER_L - 3072));
    for (int it0 = gw; it0 < nitems; it0 += NGW) {
        int l, r; const int it = (mode == 3) ? it0 + N_OTH : it0;
        if (mode == 0) { l = it / 3072; r = 2944 + it % 3072; }
        else { l = (mode == 2) ? 0 : 1; r = it < 2944 ? it : it + 3072; }
#define TR(NKB, NNB, Wp, ldw, WTp, ldk, rs) if (r < (NKB) * (NNB)) { const int kb = r / (NNB), nb = r % (NNB); tr_item((Wp), (ldw), (WTp), (ldk), kb * 64, nb * 32, (rs), scr, lane); continue; } r -= (NKB) * (NNB);
        TR(16, 184, ap->in[I_WIN] + (size_t)l * D * INC, INC, (bf16*)(ws + WS_WIN + l * SZ_WIN), D, nullptr)
        TR(16, 192, ap->in[I_ADAW] + (size_t)l * D * NMOD, NMOD, (bf16*)(ws + WS_ADA) + (size_t)l * NMOD * D, D, nullptr)
        TR(1, 32, ap->in[I_DUP] + (size_t)l * 64 * D, D, (bf16*)(ws + WS_LORA + l * SZ_LORA), 256, nullptr)
        TR(1, 32, ap->in[I_AUP] + (size_t)l * 64 * D, D, (bf16*)(ws + WS_LORA + l * SZ_LORA) + 1024 * 256 + 64, 256, nullptr)
        TR(2, 32, ap->in[I_GUP] + (size_t)l * 128 * D, D, (bf16*)(ws + WS_LORA + l * SZ_LORA) + 2048 * 256 + 128, 256, nullptr)
        TR(16, 32, ap->in[I_WBR] + (size_t)l * D * D, D, (bf16*)(ws + WS_WBR + l * SZ_WBR), D, nullptr)
        if (r < 32) { const int g = r >> 3, q = r & 7, kb = q >> 2, nb = q & 3;
            tr_item(ap->in[I_PW] + (size_t)(l * 4 + g) * 128 * 128, 128, (bf16*)(ws + WS_PW + l * SZ_PW) + (size_t)(g * 128) * 512 + g * 128, 512, kb * 64, nb * 32, ap->in[I_PS] + l * 512 + g * 128, scr, lane); continue; } r -= 32;
        TR(8, 32, ap->in[I_WBP] + (size_t)l * 512 * D, D, (bf16*)(ws + WS_WBP + l * SZ_WBP), 512, nullptr)
        TR(16, 32, ap->in[I_WOUT] + (size_t)l * D * D, D, (bf16*)(ws + WS_WOUT + l * SZ_WOUT), D, nullptr)
        if (r < 16 * 176) { const int kb = r / 176, n0 = (r % 176) * 32;
            const int pn0 = n0 < DFF ? (n0 / 128) * 256 + (n0 % 128) : ((n0 - DFF) / 128) * 256 + 128 + ((n0 - DFF) % 128);
            tr_item(ap->in[I_UP] + (size_t)l * D * FF2, FF2, (bf16*)(ws + WS_UP + l * SZ_UP) + (ptrdiff_t)(pn0 - n0) * D, D, kb * 64, n0, nullptr, scr, lane); continue; } r -= 16 * 176;
        TR(44, 32, ap->in[I_DOWN] + (size_t)l * DFF * D, D, (bf16*)(ws + WS_DOWN + l * SZ_DOWN), DFF, nullptr)
#undef TR
    }
    if (mode != 0) return;
    const int gt = bid * NTHR + tid, NGT = G * NTHR;
    const u32x4 z4 = (u32x4){0u, 0u, 0u, 0u};
    for (int i = gt; i < NL * 3072 * 32; i += NGT) { const int l = i / (3072 * 32), r = i % (3072 * 32), n = r >> 5, c = r & 31, blk = n >> 10;
        const bool diag = (blk == 0) ? (c < 8) : (blk == 1) ? (c >= 8 && c < 16) : (c >= 16);
        if (!diag) *(u32x4*)((bf16*)(ws + WS_LORA + l * SZ_LORA) + (size_t)n * 256 + c * 8) = z4; }
    for (int i = gt; i < NL * 512 * 64; i += NGT) { const int l = i / (512 * 64), r = i % (512 * 64), n = r >> 6, c = r & 63, g = n >> 7;
        if ((c >> 4) != g) *(u32x4*)((bf16*)(ws + WS_PW + l * SZ_PW) + (size_t)n * 512 + c * 8) = z4; }
    for (int i = gt; i < NL * 3072; i += NGT) { const int l = i / 3072, c = i % 3072;
        ((float*)(ws + WS_LBIAS))[i] = c < 1024 ? ap->in[I_DW0][l * D + c] : (c < 2048 ? ap->in[I_A0][l * D + c - 1024] : 0.f); }
    for (int i = gt; i < 256 * D / 2; i += NGT) { const int row = i / (D / 2), c = (i % (D / 2)) * 2; float v0 = 0.f, v1 = 0.f;
        if (row < NB) { v0 = ap->in[I_CP][row * D + c]; v1 = ap->in[I_CP][row * D + c + 1]; } else if (row < NB + DECB) { v0 = ap->in[I_CS][(row - NB) * D + c]; v1 = ap->in[I_CS][(row - NB) * D + c + 1]; }
        ((unsigned*)(ws + WS_CALL))[i] = pk2(v0, v1); }
}

__device__ __forceinline__ void rowpass_load(KArgs ap, int stage, int m, int lane, f32x4 (&v)[4]) {
    if (stage == 0) { const float* src = (m < MP ? ap->in[I_XP] + (size_t)m * D : ap->in[I_XS] + (size_t)(m - MP) * D);
#pragma unroll
        for (int j = 0; j < 2; ++j) { v[2 * j] = ldnt4(src + 8 * lane + 512 * j); v[2 * j + 1] = ldnt4(src + 8 * lane + 512 * j + 4); } }
    else { const bf16* src = (const bf16*)(ap->ws + WS_XB) + (size_t)m * D;
#pragma unroll
        for (int j = 0; j < 2; ++j) { const f8 t = ld8b(src + 8 * lane + 512 * j); v[2 * j] = t.a; v[2 * j + 1] = t.b; } }
}
__device__ __forceinline__ void phase_rowpass(KArgs ap, int stage, int l, int lane, int gw, int NGW, int mfirst, int mstep, int mend, bool do_shift) {
    unsigned char* ws = ap->ws; float* X = ap->out; bf16* H = (bf16*)(ws + WS_H); const float* MOD = (const float*)(ws + WS_MOD);
    if (do_shift && (stage == 0 || stage == 2))
        for (int m = MT + gw; m < MPAD; m += NGW) { const float* src = ap->in[I_SSHIFT] + ((size_t)l * DECB + (m - MT)) * D;
#pragma unroll
            for (int j = 0; j < 2; ++j) { f8 t; t.a = *(const f32x4*)(src + 8 * lane + 512 * j); t.b = *(const f32x4*)(src + 8 * lane + 512 * j + 4); *(u32x4*)(H + (size_t)m * D + 8 * lane + 512 * j) = pack8(t); } }
    const float* lw = (stage == 1) ? ap->in[I_LN1W] + l * D : ap->in[I_LN2W] + (l - 1) * D;
    const float* lb = (stage == 1) ? ap->in[I_LN1B] + l * D : ap->in[I_LN2B] + (l - 1) * D;
    f32x4 vn[4];
    if (mfirst < mend) rowpass_load(ap, stage, mfirst, lane, vn);
    for (int m = mfirst; m < mend; m += mstep) {
        f32x4 v[4];
#pragma unroll
        for (int j = 0; j < 4; ++j) v[j] = vn[j];
        if (m + mstep < mend) rowpass_load(ap, stage, m + mstep, lane, vn);
        if (stage != 0) {
            float s = 0.f;
#pragma unroll
            for (int j = 0; j < 4; ++j) s += hsum4(v[j]);
            const float mean = wave_sum(s) * (1.f / D); float q = 0.f;
#pragma unroll
            for (int j = 0; j < 4; ++j) { v[j] = v[j] - mean; q += hsum4(v[j] * v[j]); }
            const float rstd = 1.0f / sqrtf(wave_sum(q) * (1.f / D) + LN_EPS);
#pragma unroll
            for (int j = 0; j < 4; ++j) { const int c = 8 * lane + 512 * (j >> 1) + 4 * (j & 1); v[j] = v[j] * rstd * *(const f32x4*)(lw + c) + *(const f32x4*)(lb + c); }
        }
        if (stage == 3) {
#pragma unroll
            for (int j = 0; j < 4; ++j) stnt4(X + (size_t)m * D + 8 * lane + 512 * (j >> 1) + 4 * (j & 1), v[j]);
            continue; }
#pragma unroll
        for (int j = 0; j < 2; ++j) { f8 t; t.a = v[2 * j]; t.b = v[2 * j + 1]; *(u32x4*)((bf16*)(ws + WS_XB) + (size_t)m * D + 8 * lane + 512 * j) = pack8(t); }
        float s = 0.f;
#pragma unroll
        for (int j = 0; j < 4; ++j) s += hsum4(v[j]);
        const float mean = wave_sum(s) * (1.f / D); float q = 0.f;
#pragma unroll
        for (int j = 0; j < 4; ++j) { v[j] = v[j] - mean; q += hsum4(v[j] * v[j]); }
        const float rstd = 1.0f / sqrtf(wave_sum(q) * (1.f / D) + LN_EPS);
        const float* sh = MOD + (size_t)cidx_of(m) * NMOD2 + l * NMOD + (stage == 1 ? 3 * D : 0); const float* sc = sh + D;
        float* so = nullptr;
        if (stage != 1) { if (m >= MP) so = ap->out + O_SHS + ((size_t)l * DECB + (m - MP)) * D; else if ((m & (SEQ - 1)) == SEQ - 1) so = ap->out + O_SHP + ((size_t)l * NB + (m >> 11)) * D; }
#pragma unroll
        for (int j = 0; j < 2; ++j) { const int c = 8 * lane + 512 * j; f8 h;
            h.a = v[2 * j] * rstd * (*(const f32x4*)(sc + c) + 1.0f) + *(const f32x4*)(sh + c); h.b = v[2 * j + 1] * rstd * (*(const f32x4*)(sc + c + 4) + 1.0f) + *(const f32x4*)(sh + c + 4);
            *(u32x4*)(H + (size_t)m * D + c) = pack8(h);
            if (so) { *(f32x4*)(so + c) = h.a; *(f32x4*)(so + c + 4) = h.b; } }
    }
}

__device__ __forceinline__ void phase_prepC(KArgs ap, int l, int gt, int NGT) {
    unsigned char* ws = ap->ws; const bf16* PROJ = (const bf16*)(ws + WS_PROJ); bf16* AL = (bf16*)(ws + WS_AL); bf16* PD = (bf16*)(ws + WS_PD);
    const float* mu = ap->in[I_MU] + (size_t)l * 3328 + C_WL; const float* spool = ap->in[I_SPOOL] + (size_t)l * DECB * PBUF * DPOOL;
    constexpr int RR = 8;
    for (int idx = gt; idx < (MP / RR) * 64; idx += NGT) {
        const int rr = idx >> 6, j0 = (idx & 63) * 8, g = j0 >> 7, win = 2 << g, m0 = rr * RR, t0 = m0 & (SEQ - 1);
        const bf16* pp = PROJ + (size_t)m0 * INC + C_POOL + j0;
        f8 acc = zero8();
        for (int i = 1; i < win; ++i) if (t0 - i >= 0) acc = add8(acc, ld8b(pp - (size_t)i * INC));
#pragma unroll 4
        for (int i = 0; i < RR; ++i) {
            const int t = t0 + i; const f8 cur = ld8b(pp + (size_t)i * INC);
            acc = add8(acc, cur);
            const int n = (t + 1 < win) ? t + 1 : win; const float ic = 1.0f / (float)n;
            f8 d; d.a = acc.a * ic - cur.a; d.b = acc.b * ic - cur.b;
            *(u32x4*)(PD + (size_t)(m0 + i) * 512 + j0) = pack8(d);
            if (t - win + 1 >= 0) acc = sub8(acc, ld8b(pp + ((long)i - win + 1) * INC));
        }
    }
    for (int idx = gt; idx < DECB * 64; idx += NGT) {
        const int m = MP + (idx >> 6), j0 = (idx & 63) * 8, g = j0 >> 7, win = 2 << g; const f8 cur = ld8b(PROJ + (size_t)m * INC + C_POOL + j0); f8 acc = cur;
        const float* sp = spool + (size_t)(m - MP) * PBUF * DPOOL + j0;
        for (int i = 1; i < win; ++i) acc = add8(acc, ld8f(sp + (size_t)(PBUF - i) * DPOOL));
        const float ic = 1.0f / (float)win; f8 d; d.a = acc.a * ic - cur.a; d.b = acc.b * ic - cur.b;
        *(u32x4*)(PD + (size_t)m * 512 + j0) = pack8(d);
    }
    for (int idx = gt; idx < NB * PBUF * 64; idx += NGT) { const int c = idx & 63, i = (idx >> 6) % PBUF, b = idx / (64 * PBUF);
        const f8 v = ld8b(PROJ + (size_t)(b * SEQ + SEQ - PBUF + i) * INC + C_POOL + c * 8); float* o = ap->out + O_POOLP + (((size_t)l * NB + b) * PBUF + i) * DPOOL + c * 8;
        *(f32x4*)o = v.a; *(f32x4*)(o + 4) = v.b; }
    for (int idx = gt; idx < DECB * PBUF * 64; idx += NGT) { const int c = idx & 63, i = (idx >> 6) % PBUF, b = idx / (64 * PBUF);
        const f8 v = (i < PBUF - 1) ? ld8f(spool + ((size_t)b * PBUF + i + 1) * DPOOL + c * 8) : ld8b(PROJ + (size_t)(MP + b) * INC + C_POOL + c * 8);
        float* o = ap->out + O_POOLS + (((size_t)l * DECB + b) * PBUF + i) * DPOOL + c * 8; *(f32x4*)o = v.a; *(f32x4*)(o + 4) = v.b; }
}

struct ScanRaw { u32x4 cr, ck, cv, pr, pk, pv, dd, aa, gg; };
__device__ __forceinline__ ScanRaw scan_load(const bf16* PROJ, const bf16* LO, const bf16* R63g, int m, int cofs, bool has_prev) {
    ScanRaw r; const bf16* p = PROJ + (size_t)m * INC + cofs; const u32x4 z = (u32x4){0u, 0u, 0u, 0u};
    r.cr = *(const u32x4*)(p + C_R); r.ck = *(const u32x4*)(p + C_K); r.cv = *(const u32x4*)(p + C_V);
    r.pr = z; r.pk = z; r.pv = z;
    if (has_prev) { const bf16* q = R63g + (size_t)((m >> 6) - 1) * 3328 + cofs; r.pr = *(const u32x4*)(q + C_R); r.pk = *(const u32x4*)(q + C_K); r.pv = *(const u32x4*)(q + C_V); }
    const bf16* q = LO + (size_t)m * 3072 + cofs; r.dd = *(const u32x4*)q; r.aa = *(const u32x4*)(q + 1024); r.gg = *(const u32x4*)(q + 2048);
    return r;
}
__device__ __forceinline__ void st8lds(LAS float* p, f8 v) { *(LAS f32x4*)p = v.a; *(LAS f32x4*)(p + 4) = v.b; }
__device__ __forceinline__ f8 ld8lds(const LAS float* p) { f8 r; r.a = *(const LAS f32x4*)p; r.b = *(const LAS f32x4*)(p + 4); return r; }
__device__ __forceinline__ void phase_scan(KArgs ap, int l, LAS unsigned char* lds, int tid, int lane, int wave, int bid, int G) {
    unsigned char* ws = ap->ws; const bf16* PROJ = (const bf16*)(ws + WS_PROJ); const bf16* LO = (const bf16*)(ws + WS_LO); bf16* Y = (bf16*)(ws + WS_Y); float* RK = (float*)(ws + WS_RK);
    LAS float* vec = (LAS float*)lds; LAS float* yb = (LAS float*)(lds + 98304); LAS float* cst = (LAS float*)(lds + 106496);
    const float* mu = ap->in[I_MU] + (size_t)l * 3328;
    {
        typedef short bf16x4 __attribute__((ext_vector_type(4)));
        constexpr int L_LW = 0, L_GC = 16384, L_GCLOG = 17408, L_CST = 18432, L_CH = 20480, CHB = 22784;
        constexpr int C_KT = 0, C_RT = 2304, C_BT = 4608, C_KK = 6912, C_KG = 9216, C_BG = 12288, C_VT = 15360, C_AKK = 18432, C_BBR = 19200, C_BKR = 19968, C_TT = 20736, C_AKB = 21504;
        LAS float* YR = (LAS float*)(lds + 112640);
        LAS float* LW = (LAS float*)(lds + L_LW); LAS float* GCx = (LAS float*)(lds + L_GC); LAS float* GCL = (LAS float*)(lds + L_GCLOG); LAS float* cs2 = (LAS float*)(lds + L_CST);
#define CHP(cq, off) ((LAS bf16*)(lds + L_CH + (cq) * CHB + (off)))
#define BARRIER() asm volatile("s_waitcnt lgkmcnt(0)\n\ts_barrier" ::: "memory")
        const int nitems = NB * NH;
        for (int item = bid; item < nitems; item += G) {
            const int b = item >> 4, h = item & 15, mbase = b * SEQ;
            __syncthreads();
            if (tid < 64) { const int c = h * 64 + tid;
                cs2[tid] = mu[C_R + c]; cs2[64 + tid] = mu[C_K + c]; cs2[128 + tid] = mu[C_V + c];
                cs2[192 + tid] = ap->in[I_KK][l * D + c]; cs2[256 + tid] = ap->in[I_KA][l * D + c]; cs2[320 + tid] = ap->in[I_RK][l * D + c];
                cs2[384 + tid] = ap->in[I_GNW][l * D + c]; cs2[448 + tid] = ap->in[I_GNB][l * D + c]; }
            __syncthreads();
            const int tt = tid >> 3, jo = tid & 7, cofs = h * 64 + jo * 8, cq = tt >> 4, tl = tt & 15;
            const int li = lane & 15, lq = lane >> 4;
            const f32x4 z4 = (f32x4){0.f, 0.f, 0.f, 0.f};
            f32x4 S0 = z4, S1 = z4, S2 = z4, S3 = z4;
            const bf16* R63g = (const bf16*)(ws + WS_R63);
            ScanRaw raw = scan_load(PROJ, LO, R63g, mbase + tt, cofs, false);
            for (int sc = 0; sc < SEQ / 64; ++sc) {
                const int m0 = mbase + sc * 64;
                f8 r8 = unpack8(raw.cr), k8 = unpack8(raw.ck), v8 = unpack8(raw.cv);
                if (tt == 0) { r8 = mix8(r8, unpack8(raw.pr), ld8lds(cs2 + jo * 8)); k8 = mix8(k8, unpack8(raw.pk), ld8lds(cs2 + 64 + jo * 8)); v8 = mix8(v8, unpack8(raw.pv), ld8lds(cs2 + 128 + jo * 8)); }
                const f8 lw8 = scl8(sigm8(unpack8(raw.dd)), -0.60653065971f);
                const f8 av = sigm8(unpack8(raw.aa)); const u32x4 gate_raw = raw.gg;
                if (sc + 1 < SEQ / 64) raw = scan_load(PROJ, LO, R63g, m0 + 64 + tt, cofs, tt == 0);
                f8 kk8 = mul8(k8, ld8lds(cs2 + 192 + jo * 8));
                { const float ss = red8(hsum8(mul8(kk8, kk8))); kk8 = scl8(kk8, 1.0f / fmaxf(sqrtf(ss), 1e-12f)); }
                const f8 ka = ld8lds(cs2 + 256 + jo * 8); f8 kp8; kp8.a = k8.a * ((av.a - 1.0f) * ka.a + 1.0f); kp8.b = k8.b * ((av.b - 1.0f) * ka.b + 1.0f);
                const f8 bb8 = mul8(kk8, av);
                const float rk = red8(hsum8(mul8(mul8(r8, kp8), ld8lds(cs2 + 320 + jo * 8))));
                st8lds(LW + tt * 64 + jo * 8, lw8);
                { LAS bf16* vt = CHP(cq, C_VT) + (jo * 8) * 24 + tl;
                  const u32x4 pv = pack8(v8);
                  vt[0 * 24] = (bf16)(pv.x & 0xffffu); vt[1 * 24] = (bf16)(pv.x >> 16); vt[2 * 24] = (bf16)(pv.y & 0xffffu); vt[3 * 24] = (bf16)(pv.y >> 16);
                  vt[4 * 24] = (bf16)(pv.z & 0xffffu); vt[5 * 24] = (bf16)(pv.z >> 16); vt[6 * 24] = (bf16)(pv.w & 0xffffu); vt[7 * 24] = (bf16)(pv.w >> 16); }
                BARRIER();
                if (tid < 256) { const int q = tid >> 6, k = tid & 63; float gv[16];
#pragma unroll
                    for (int t = 0; t < 16; ++t) gv[t] = LW[(q * 16 + t) * 64 + k];
#pragma unroll
                    for (int t = 1; t < 16; ++t) gv[t] += gv[t - 1];
#pragma unroll
                    for (int t = 0; t < 16; ++t) { gv[t] = __expf(gv[t]); LW[(q * 16 + t) * 64 + k] = gv[t]; }
                    GCL[q * 64 + k] = gv[15]; GCx[q * 64 + k] = gv[15]; }
                BARRIER();
                {   const f8 e = ld8lds(LW + tt * 64 + jo * 8); f8 ep; ep.a = (f32x4){1.f, 1.f, 1.f, 1.f}; ep.b = ep.a; if (tl > 0) ep = ld8lds(LW + (tt - 1) * 64 + jo * 8); const f8 gc = ld8lds(GCx + cq * 64 + jo * 8);
                    f8 ie; ie.a = (f32x4){__builtin_amdgcn_rcpf(e.a.x), __builtin_amdgcn_rcpf(e.a.y), __builtin_amdgcn_rcpf(e.a.z), __builtin_amdgcn_rcpf(e.a.w)};
                    ie.b = (f32x4){__builtin_amdgcn_rcpf(e.b.x), __builtin_amdgcn_rcpf(e.b.y), __builtin_amdgcn_rcpf(e.b.z), __builtin_amdgcn_rcpf(e.b.w)};
                    const f8 eg = mul8(gc, ie);
                    *(LAS u32x4*)(CHP(cq, C_KT) + tl * 72 + jo * 8) = pack8(mul8(kk8, ep));
                    *(LAS u32x4*)(CHP(cq, C_RT) + tl * 72 + jo * 8) = pack8(mul8(r8, e));
                    *(LAS u32x4*)(CHP(cq, C_BT) + tl * 72 + jo * 8) = pack8(mul8(bb8, ie));
                    *(LAS u32x4*)(CHP(cq, C_KK) + tl * 72 + jo * 8) = pack8(mul8(kp8, ie));
                    const u32x4 pk = pack8(mul8(kp8, eg)), pb = pack8(mul8(bb8, eg));
                    LAS bf16* kg = CHP(cq, C_KG) + (jo * 8) * 24 + tl; LAS bf16* bg = CHP(cq, C_BG) + (jo * 8) * 24 + tl;
                    kg[0 * 24] = (bf16)(pk.x & 0xffffu); kg[1 * 24] = (bf16)(pk.x >> 16); kg[2 * 24] = (bf16)(pk.y & 0xffffu); kg[3 * 24] = (bf16)(pk.y >> 16);
                    kg[4 * 24] = (bf16)(pk.z & 0xffffu); kg[5 * 24] = (bf16)(pk.z >> 16); kg[6 * 24] = (bf16)(pk.w & 0xffffu); kg[7 * 24] = (bf16)(pk.w >> 16);
                    bg[0 * 24] = (bf16)(pb.x & 0xffffu); bg[1 * 24] = (bf16)(pb.x >> 16); bg[2 * 24] = (bf16)(pb.y & 0xffffu); bg[3 * 24] = (bf16)(pb.y >> 16);
                    bg[4 * 24] = (bf16)(pb.z & 0xffffu); bg[5 * 24] = (bf16)(pb.z >> 16); bg[6 * 24] = (bf16)(pb.w & 0xffffu); bg[7 * 24] = (bf16)(pb.w >> 16); }
                BARRIER();
                if (wave < 4) { const int q = wave;
                    f32x4 mkb = z4, mkk = z4, mbr = z4, mkr = z4;
#pragma unroll
                    for (int ks = 0; ks < 2; ++ks) { const int o = li * 72 + ks * 32 + lq * 8;
                        const pg8::bf16x8 xb = *(const LAS pg8::bf16x8*)(CHP(q, C_BT) + o), xk = *(const LAS pg8::bf16x8*)(CHP(q, C_KK) + o), yk = *(const LAS pg8::bf16x8*)(CHP(q, C_KT) + o), yr = *(const LAS pg8::bf16x8*)(CHP(q, C_RT) + o);
                        mkb = __builtin_amdgcn_mfma_f32_16x16x32_bf16(xb, yk, mkb, 0, 0, 0); mkk = __builtin_amdgcn_mfma_f32_16x16x32_bf16(xk, yk, mkk, 0, 0, 0);
                        mbr = __builtin_amdgcn_mfma_f32_16x16x32_bf16(xb, yr, mbr, 0, 0, 0); mkr = __builtin_amdgcn_mfma_f32_16x16x32_bf16(xk, yr, mkr, 0, 0, 0); }
                    const int t = li, j0 = 4 * lq;
                    const f32x4 ms = (f32x4){j0 < t ? 1.f : 0.f, j0 + 1 < t ? 1.f : 0.f, j0 + 2 < t ? 1.f : 0.f, j0 + 3 < t ? 1.f : 0.f};
                    const f32x4 me = (f32x4){j0 <= t ? 1.f : 0.f, j0 + 1 <= t ? 1.f : 0.f, j0 + 2 <= t ? 1.f : 0.f, j0 + 3 <= t ? 1.f : 0.f};
                    mkb = mkb * ms; mkk = mkk * ms; mbr = mbr * me; mkr = mkr * me;
                    u32x2 w; w.x = pk2(mkk.x, mkk.y); w.y = pk2(mkk.z, mkk.w); *(LAS u32x2*)(CHP(q, C_AKK) + t * 24 + j0) = w;
                    w.x = pk2(mbr.x, mbr.y); w.y = pk2(mbr.z, mbr.w); *(LAS u32x2*)(CHP(q, C_BBR) + t * 24 + j0) = w;
                    w.x = pk2(mkr.x, mkr.y); w.y = pk2(mkr.z, mkr.w); *(LAS u32x2*)(CHP(q, C_BKR) + t * 24 + j0) = w;
                    {   typedef short bf16x4 __attribute__((ext_vector_type(4)));
                        LAS bf16* BR = CHP(q, C_AKB);
                        f32x4 Bn = -mkb;
                        f32x4 Pn = Bn + (f32x4){j0 == t ? 1.f : 0.f, j0 + 1 == t ? 1.f : 0.f, j0 + 2 == t ? 1.f : 0.f, j0 + 3 == t ? 1.f : 0.f};
#pragma unroll
                        for (int n = 0; n < 3; ++n) {
                            { const unsigned w0 = pk2(Bn.x, Bn.y), w1 = pk2(Bn.z, Bn.w); LAS bf16* p = BR + j0 * 24 + t;
                              p[0] = (bf16)(w0 & 0xffffu); p[24] = (bf16)(w0 >> 16); p[48] = (bf16)(w1 & 0xffffu); p[72] = (bf16)(w1 >> 16); }
                            asm volatile("s_waitcnt lgkmcnt(0)" ::: "memory");
                            const bf16x4 brow = *(const LAS bf16x4*)(BR + li * 24 + 4 * lq);
                            u32x2 cb; cb.x = pk2(Bn.x, Bn.y); cb.y = pk2(Bn.z, Bn.w);
                            const f32x4 Bsq = __builtin_amdgcn_mfma_f32_16x16x16bf16_1k(brow, __builtin_bit_cast(bf16x4, cb), z4, 0, 0, 0);
                            asm volatile("s_waitcnt lgkmcnt(0)" ::: "memory");
                            { const unsigned w0 = pk2(Bsq.x, Bsq.y), w1 = pk2(Bsq.z, Bsq.w); LAS bf16* p = BR + j0 * 24 + t;
                              p[0] = (bf16)(w0 & 0xffffu); p[24] = (bf16)(w0 >> 16); p[48] = (bf16)(w1 & 0xffffu); p[72] = (bf16)(w1 >> 16); }
                            asm volatile("s_waitcnt lgkmcnt(0)" ::: "memory");
                            const bf16x4 b1row = *(const LAS bf16x4*)(BR + li * 24 + 4 * lq);
                            u32x2 cp; cp.x = pk2(Pn.x, Pn.y); cp.y = pk2(Pn.z, Pn.w);
                            Pn = __builtin_amdgcn_mfma_f32_16x16x16bf16_1k(b1row, __builtin_bit_cast(bf16x4, cp), Pn, 0, 0, 0);
                            asm volatile("s_waitcnt lgkmcnt(0)" ::: "memory");
                            Bn = Bsq;
                        }
                        w.x = pk2(Pn.x, Pn.y); w.y = pk2(Pn.z, Pn.w); *(LAS u32x2*)(CHP(q, C_TT) + t * 24 + j0) = w;
                    }
                }
                BARRIER();
                if (wave >= 4) { const int v0 = (wave - 4) * 16;
#define F4(q, off, row, stride, col) (*(const LAS bf16x4*)(CHP(q, off) + (row) * (stride) + (col)))
#define CVT4(A_) ({ const f32x4 t_ = (A_); u32x2 w_; w_.x = pk2(t_.x, t_.y); w_.y = pk2(t_.z, t_.w); __builtin_bit_cast(bf16x4, w_); })
#define MF16(a, b, c) __builtin_amdgcn_mfma_f32_16x16x16bf16_1k(a, b, c, 0, 0, 0)
                    for (int q = 0; q < 4; ++q) {
                        const bf16x4 s0 = CVT4(S0), s1 = CVT4(S1), s2 = CVT4(S2), s3 = CVT4(S3);
                        const bf16x4 vf = F4(q, C_VT, v0 + li, 24, 4 * lq);
                        f32x4 aw = z4;
                        aw = MF16(F4(q, C_KT, li, 72, 0 + 4 * lq), s0, aw); aw = MF16(F4(q, C_KT, li, 72, 16 + 4 * lq), s1, aw);
                        aw = MF16(F4(q, C_KT, li, 72, 32 + 4 * lq), s2, aw); aw = MF16(F4(q, C_KT, li, 72, 48 + 4 * lq), s3, aw);
                        aw = MF16(F4(q, C_AKK, li, 24, 4 * lq), vf, aw);
                        f32x4 au = MF16(F4(q, C_TT, li, 24, 4 * lq), CVT4(aw), z4);
                        au = -au; const bf16x4 nu = CVT4(au);
                        f32x4 ay = z4;
                        ay = MF16(F4(q, C_RT, li, 72, 0 + 4 * lq), s0, ay); ay = MF16(F4(q, C_RT, li, 72, 16 + 4 * lq), s1, ay);
                        ay = MF16(F4(q, C_RT, li, 72, 32 + 4 * lq), s2, ay); ay = MF16(F4(q, C_RT, li, 72, 48 + 4 * lq), s3, ay);
                        ay = MF16(F4(q, C_BKR, li, 24, 4 * lq), vf, ay); ay = MF16(F4(q, C_BBR, li, 24, 4 * lq), nu, ay);
                        { LAS float* yp = YR + (q * 16 + 4 * lq) * 68 + v0 + li; yp[0] = ay.x; yp[68] = ay.y; yp[136] = ay.z; yp[204] = ay.w; }
                        const LAS float* gcp = GCx + q * 64 + 4 * lq;
                        S0 = S0 * *(const LAS f32x4*)(gcp); S1 = S1 * *(const LAS f32x4*)(gcp + 16); S2 = S2 * *(const LAS f32x4*)(gcp + 32); S3 = S3 * *(const LAS f32x4*)(gcp + 48);
                        S0 = MF16(F4(q, C_KG, 0 + li, 24, 4 * lq), vf, S0); S0 = MF16(F4(q, C_BG, 0 + li, 24, 4 * lq), nu, S0);
                        S1 = MF16(F4(q, C_KG, 16 + li, 24, 4 * lq), vf, S1); S1 = MF16(F4(q, C_BG, 16 + li, 24, 4 * lq), nu, S1);
                        S2 = MF16(F4(q, C_KG, 32 + li, 24, 4 * lq), vf, S2); S2 = MF16(F4(q, C_BG, 32 + li, 24, 4 * lq), nu, S2);
                        S3 = MF16(F4(q, C_KG, 48 + li, 24, 4 * lq), vf, S3); S3 = MF16(F4(q, C_BG, 48 + li, 24, 4 * lq), nu, S3);
                    }
#undef F4
#undef CVT4
#undef MF16
                }
                BARRIER();
                {   f8 y = ld8lds(YR + tt * 68 + jo * 8);
                    const float mean = red8(hsum8(y)) * (1.0f / 64.0f); y.a = y.a - mean; y.b = y.b - mean;
                    const float var = red8(hsum8(mul8(y, y))) * (1.0f / 64.0f); const float rstd = 1.0f / sqrtf(var + GN_EPS);
                    const f8 gw = ld8lds(cs2 + 384 + jo * 8), gb = ld8lds(cs2 + 448 + jo * 8), gt8 = unpack8(gate_raw);
                    f8 o; o.a = (y.a * rstd * gw.a + gb.a + v8.a * rk) * gt8.a; o.b = (y.b * rstd * gw.b + gb.b + v8.b * rk) * gt8.b;
                    *(u32x4*)(Y + (size_t)(m0 + tt) * D + cofs) = pack8(o); }
            }
            if (wave >= 4) { float* o = ap->out + O_WKVP + (((size_t)l * NB + b) * NH + h) * 4096 + (size_t)((wave - 4) * 16 + li) * 64 + 4 * lq;
                *(f32x4*)o = S0; *(f32x4*)(o + 16) = S1; *(f32x4*)(o + 32) = S2; *(f32x4*)(o + 48) = S3; }
        }
#undef CHP
#undef BARRIER
    }
    {
        LAS float* wv = (LAS float*)(lds + 112640 + wave * 1536);
        for (int it = bid * NWAVES + wave; it < DECB * NH; it += G * NWAVES) {
            const int i = it >> 4, h = it & 15, m = MP + i; float rk;
            { const int c = h * 64 + lane; const bf16* p = PROJ + (size_t)m * INC + c; const bf16* q = p + (size_t)DECB * INC;
              const float mr = mu[C_R + c], mk = mu[C_K + c], mv = mu[C_V + c];
              const float r = bf1(p[C_R]), k = bf1(p[C_K]), v = bf1(p[C_V]); (void)q; (void)mr; (void)mk; (void)mv;
              const float w = __expf(-0.60653065971f * sigm(bf1(LO[(size_t)m * 3072 + c]))); const float av = sigm(bf1(LO[(size_t)m * 3072 + 1024 + c]));
              float kk = k * ap->in[I_KK][l * D + c]; const float ss = wave_sum(kk * kk); kk *= 1.0f / fmaxf(sqrtf(ss), 1e-12f);
              const float kp = k * (1.0f + (av - 1.0f) * ap->in[I_KA][l * D + c]); const float bb = kk * av;
              rk = wave_sum(r * kp * ap->in[I_RK][l * D + c]);
              asm volatile("s_waitcnt lgkmcnt(0)" ::: "memory");
              wv[lane] = kk; wv[64 + lane] = w; wv[128 + lane] = bb; wv[192 + lane] = kp; wv[256 + lane] = r; wv[320 + lane] = v; }
            asm volatile("s_waitcnt lgkmcnt(0)" ::: "memory");
            const int kq = lane & 7, r0 = lane >> 3;
            const f8 kk = ld8lds(wv + kq * 8), w = ld8lds(wv + 64 + kq * 8), bb = ld8lds(wv + 128 + kq * 8), k8 = ld8lds(wv + 192 + kq * 8), r8 = ld8lds(wv + 256 + kq * 8);
            const size_t so = (((size_t)l * DECB + i) * NH + h) * 4096 + (size_t)r0 * 64 + kq * 8;
            const float* sp = ap->in[I_SWKV] + so; float* op = ap->out + O_WKVS + so;
            f8 st[8]; float yv[8];
#pragma unroll
            for (int j = 0; j < 8; ++j) { st[j].a = ldnt4(sp + j * 512); st[j].b = ldnt4(sp + j * 512 + 4); }
#pragma unroll
            for (int j = 0; j < 8; ++j) {
                const float v = wv[320 + r0 + 8 * j];
                f8 s = st[j];
                const float sa = red8(hsum8(mul8(s, kk)));
                s.a = s.a * w.a + (k8.a * v - bb.a * sa); s.b = s.b * w.b + (k8.b * v - bb.b * sa);
                yv[j] = red8(hsum8(mul8(s, r8)));
                stnt4(op + j * 512, s.a); stnt4(op + j * 512 + 4, s.b);
            }
            float ys = 0.f;
#pragma unroll
            for (int j = 0; j < 8; ++j) ys += yv[j];
            const float mean = wave_sum(ys) * (1.0f / 512.0f); float q2 = 0.f;
#pragma unroll
            for (int j = 0; j < 8; ++j) { yv[j] -= mean; q2 += yv[j] * yv[j]; }
            const float rstd = 1.0f / sqrtf(wave_sum(q2) * (1.0f / 512.0f) + GN_EPS);
            if (kq == 0) {
#pragma unroll
                for (int j = 0; j < 8; ++j) { const int row = r0 + 8 * j, c = h * 64 + row;
                    const float o = (yv[j] * rstd * ap->in[I_GNW][l * D + c] + ap->in[I_GNB][l * D + c] + rk * wv[320 + row]) * bf1(LO[(size_t)m * 3072 + 2048 + c]);
                    Y[(size_t)m * D + c] = (bf16)(pk2(o, 0.f) & 0xffffu); } }
        }
    }
}

__device__ __forceinline__ void phase_post(KArgs ap, int l, int gt, int NGT) {
    unsigned char* ws = ap->ws; const bf16* PROJ = (const bf16*)(ws + WS_PROJ); const bf16* LO = (const bf16*)(ws + WS_LO); bf16* Y = (bf16*)(ws + WS_Y); const float* RK = (const float*)(ws + WS_RK);
    const float* muv = ap->in[I_MU] + (size_t)l * 3328 + C_V; const float* gnw = ap->in[I_GNW] + l * D; const float* gnb = ap->in[I_GNB] + l * D;
    for (int idx = MP * 128 + gt; idx < MT * 128; idx += NGT) {
        const int m = idx >> 7, c0 = (idx & 127) * 8, h = c0 >> 6;
        f8 y = ld8b(Y + (size_t)m * D + c0);
        const float mean = red8(hsum8(y)) * (1.0f / 64.0f); y.a = y.a - mean; y.b = y.b - mean;
        const float var = red8(hsum8(mul8(y, y))) * (1.0f / 64.0f); const float rstd = 1.0f / sqrtf(var + GN_EPS);
        const f8 cur = ld8b(PROJ + (size_t)m * INC + C_V + c0); const int pr = prev_row(m);
        const f8 prev = pr >= 0 ? ld8b(PROJ + (size_t)pr * INC + C_V + c0) : zero8();
        const f8 v = mix8(cur, prev, ld8f(muv + c0));
        const float rk = RK[(size_t)m * 16 + h]; const f8 g = ld8b(LO + (size_t)m * 3072 + 2048 + c0); const f8 gw = ld8f(gnw + c0), gb = ld8f(gnb + c0);
        f8 o; o.a = (y.a * rstd * gw.a + gb.a + v.a * rk) * g.a; o.b = (y.b * rstd * gw.b + gb.b + v.b * rk) * g.b;
        *(u32x4*)(Y + (size_t)m * D + c0) = pack8(o);
    }
}

__device__ __forceinline__ f8 conv8(f8 u0, f8 u1, f8 u2, const float* cw, const float* cb, int c) {
    const f8 w0 = ld8f(cw + c), w1 = ld8f(cw + FF2 + c), w2 = ld8f(cw + 2 * FF2 + c), bb = ld8f(cb + c); f8 r;
    r.a = bb.a + u0.a * w0.a + u1.a * w1.a + u2.a * w2.a; r.b = bb.b + u0.b * w0.b + u1.b * w1.b + u2.b * w2.b; return r;
}
__device__ __forceinline__ int up_col(int c) { return c < DFF ? (c / 128) * 256 + (c % 128) : ((c - DFF) / 128) * 256 + 128 + ((c - DFF) % 128); }
__device__ __forceinline__ void phase_conv(KArgs ap, int l, int gt, int NGT) {
    unsigned char* ws = ap->ws; const bf16* U = (const bf16*)(ws + WS_U); bf16* ACT = (bf16*)(ws + WS_ACT);
    const float* cw = ap->in[I_CW] + (size_t)l * 3 * FF2; const float* cb = ap->in[I_CB] + (size_t)l * FF2; const float* sconv = ap->in[I_SCONV] + (size_t)l * DECB * 2 * FF2;
    for (int idx = gt; idx < (MP / 64) * 704; idx += NGT) {
        const int blk = idx / 704, rem = idx % 704, m = blk * 64 + rem / 352, f0 = (rem % 352) * 8, t = m & (SEQ - 1);
        const bf16* up = U + (size_t)m * FF2 + up_col(f0);
        const f8 v2 = ld8b(up), g2 = ld8b(up + 128); f8 v1 = zero8(), g1 = v1, v0 = v1, g0 = v1;
        if (t >= 1) { v1 = ld8b(up - FF2); g1 = ld8b(up - FF2 + 128); }
        if (t >= 2) { v0 = ld8b(up - 2 * FF2); g0 = ld8b(up - 2 * FF2 + 128); }
        const f8 val = conv8(v0, v1, v2, cw, cb, f0), gate = conv8(g0, g1, g2, cw, cb, f0 + DFF);
        const f8 sg = sigm8(gate); f8 o; o.a = val.a * gate.a * sg.a; o.b = val.b * gate.b * sg.b;
        *(u32x4*)(ACT + (size_t)m * DFF + f0) = pack8(o);
    }
    for (int idx = gt; idx < DECB * 352; idx += NGT) {
        const int m = MP + idx / 352, f0 = (idx % 352) * 8;
        const bf16* up = U + (size_t)m * FF2 + up_col(f0);
        const f8 v2 = ld8b(up), g2 = ld8b(up + 128);
        const float* sp = sconv + (size_t)(m - MP) * 2 * FF2 + f0; const f8 v0 = ld8f(sp), g0 = ld8f(sp + DFF), v1 = ld8f(sp + FF2), g1 = ld8f(sp + FF2 + DFF);
        const f8 val = conv8(v0, v1, v2, cw, cb, f0), gate = conv8(g0, g1, g2, cw, cb, f0 + DFF);
        const f8 sg = sigm8(gate); f8 o; o.a = val.a * gate.a * sg.a; o.b = val.b * gate.b * sg.b;
        *(u32x4*)(ACT + (size_t)m * DFF + f0) = pack8(o);
    }
    for (int idx = gt; idx < NB * 2 * 704; idx += NGT) { const int c = (idx % 704) * 8, i = (idx / 704) & 1, b = idx / 1408;
        const f8 v = ld8b(U + (size_t)(b * SEQ + SEQ - 2 + i) * FF2 + up_col(c)); float* o = ap->out + O_CONVP + (((size_t)l * NB + b) * 2 + i) * FF2 + c; *(f32x4*)o = v.a; *(f32x4*)(o + 4) = v.b; }
    for (int idx = gt; idx < DECB * 2 * 704; idx += NGT) { const int c = (idx % 704) * 8, i = (idx / 704) & 1, b = idx / 1408;
        const f8 v = (i == 0) ? ld8f(sconv + ((size_t)b * 2 + 1) * FF2 + c) : ld8b(U + (size_t)(MP + b) * FF2 + up_col(c));
        float* o = ap->out + O_CONVS + (((size_t)l * DECB + b) * 2 + i) * FF2 + c; *(f32x4*)o = v.a; *(f32x4*)(o + 4) = v.b; }
}

__device__ __forceinline__ void skinny_part(const bf16* A, const bf16* Bt, int K, int row0, int col0, int wave, int lane, f32x4& acc0, f32x4& acc1) {
    const int i = lane & 15, q = lane >> 4, ks = K >> 3, kbeg = wave * ks;
    const bf16* pa0 = A + (size_t)(row0 + i) * K + kbeg + 8 * q; const bf16* pa1 = pa0 + (size_t)16 * K; const bf16* pb = Bt + (size_t)(col0 + i) * K + kbeg + 8 * q;
    for (int k = 0; k < ks; k += 32) { const pg8::bf16x8 b = *(const pg8::bf16x8*)(pb + k), a0 = *(const pg8::bf16x8*)(pa0 + k), a1 = *(const pg8::bf16x8*)(pa1 + k);
        acc0 = __builtin_amdgcn_mfma_f32_16x16x32_bf16(b, a0, acc0, 0, 0, 0); acc1 = __builtin_amdgcn_mfma_f32_16x16x32_bf16(b, a1, acc1, 0, 0, 0); }
}
__device__ __forceinline__ f32x4 skinny_sum(const LAS float* red, int t) { f32x4 s = *(const LAS f32x4*)(red + t * 4);
#pragma unroll
    for (int w = 1; w < 8; ++w) s += *(const LAS f32x4*)(red + (w * 128 + t) * 4);
    return s; }
template <int MODE> __device__ __forceinline__ void skinny_phase(KArgs ap, int l, int jmod, const bf16* A1, const bf16* W1, int K1, const bf16* A2, const bf16* W2, int K2,
                                                                  LAS unsigned char* lds, int tid, int lane, int wave, int bid, int G) {
    unsigned char* ws = ap->ws; LAS float* red1 = (LAS float*)lds; LAS float* red2 = (LAS float*)(lds + 16384);
    for (int u = bid; u < 256; u += G) {
        const int row0 = MP + (u & 3) * 32, col0 = (u >> 2) * 16; const f32x4 z = (f32x4){0.f, 0.f, 0.f, 0.f};
        f32x4 a0 = z, a1 = z, c0 = z, c1 = z;
        skinny_part(A1, W1, K1, row0, col0, wave, lane, a0, a1);
        if (MODE == 0) skinny_part(A2, W2, K2, row0, col0, wave, lane, c0, c1);
        __syncthreads();
        *(LAS f32x4*)(red1 + ((wave * 2 + 0) * 64 + lane) * 4) = a0; *(LAS f32x4*)(red1 + ((wave * 2 + 1) * 64 + lane) * 4) = a1;
        if (MODE == 0) { *(LAS f32x4*)(red2 + ((wave * 2 + 0) * 64 + lane) * 4) = c0; *(LAS f32x4*)(red2 + ((wave * 2 + 1) * 64 + lane) * 4) = c1; }
        __syncthreads();
        if (tid < 128) { const int rt = tid >> 6, ln = tid & 63, row = row0 + 16 * rt + (ln & 15), col = col0 + 4 * (ln >> 4);
            const f32x4 s1 = skinny_sum(red1, tid);
            if (MODE == 0) { const f32x4 s2 = skinny_sum(red2, tid); const bf16* pj = (const bf16*)(ws + WS_PROJ) + (size_t)row * INC + col;
                const f32x4 o = sigm4(ld4b(pj + C_GP)) * s1 + sigm4(ld4b(pj + C_GR)) * s2; u32x2 w; w.x = pk2(o.x, o.y); w.y = pk2(o.z, o.w);
                *(u32x2*)((bf16*)(ws + WS_MG) + (size_t)row * D + col) = w; }
            else { bf16* xp = (bf16*)(ws + WS_XB) + (size_t)row * D + col; const f32x4 g = *(const f32x4*)((const float*)(ws + WS_MOD) + (size_t)cidx_of(row) * NMOD2 + l * NMOD + jmod * D + col);
                const f32x4 r = ld4b(xp) * ALPHA + (g + 1.0f) * s1; u32x2 w; w.x = pk2(r.x, r.y); w.y = pk2(r.z, r.w); *(u32x2*)xp = w; } }
    }
    __syncthreads();
}

#define XB_TMO      128
#define XB_XCNT(j)  (256  + 64 * (j))
#define XB_XSUB(j)  (1280 + 64 * (j))
#define XB_XGEN(j)  (2304 + 64 * (j))
#define XB_TOP      3328
#define XB_TOPGEN   3392
#define XCD_BAR_WORDS 3456
#define XB_SPIN_CAP (1u << 18)

__device__ __forceinline__ unsigned xb_ld(unsigned* p)              { return __hip_atomic_load(p, __ATOMIC_RELAXED, __HIP_MEMORY_SCOPE_AGENT); }
__device__ __forceinline__ unsigned xb_add(unsigned* p, unsigned v) { return __hip_atomic_fetch_add(p, v, __ATOMIC_RELAXED, __HIP_MEMORY_SCOPE_AGENT); }
__device__ __forceinline__ unsigned xb_xcc_id() { return (unsigned)__builtin_amdgcn_s_getreg((3 << 11) | 20) & 0xFu; }
#define XB_SPIN(cond, bar) do { unsigned _sp = 0; while (cond) { __builtin_amdgcn_s_sleep(1); \
    if ((++_sp & 255u) == 0u) { if (xb_ld(&(bar)[XB_TMO])) break; if (_sp > XB_SPIN_CAP) { atomicAdd(&(bar)[XB_TMO], 1u); break; } } } } while (0)

struct XcdBarrier {
    unsigned* bar; unsigned x;
    volatile LAS unsigned* st;
};

__device__ __forceinline__ XcdBarrier xcd_barrier_post(unsigned* bar, volatile LAS unsigned* st) {
    XcdBarrier b; b.bar = bar; b.x = xb_xcc_id(); b.st = st;
    if (threadIdx.x == 0) (void)xb_add(&bar[XB_XCNT(b.x)], 1u);
    return b;
}
__device__ __forceinline__ void xcd_barrier_complete(unsigned* bar, unsigned x, unsigned& nloc, unsigned& nx) {
    const unsigned G = gridDim.x * gridDim.y * gridDim.z;
    unsigned sum, cnt, mine, sp = 0u;
    for (;;) {
        sum = 0u; cnt = 0u; mine = 0u;
#pragma unroll
        for (unsigned j = 0; j < 16; ++j) { const unsigned c = xb_ld(&bar[XB_XCNT(j)]); sum += c; cnt += (c > 0u) ? 1u : 0u; mine = (j == x) ? c : mine; }
        if (sum == G) break;
        __builtin_amdgcn_s_sleep(1);
        if ((++sp & 255u) == 0u) { if (xb_ld(&bar[XB_TMO])) break; if (sp > XB_SPIN_CAP) { atomicAdd(&bar[XB_TMO], 1u); break; } }
    }
    nloc = mine > 0u ? mine : 1u; nx = cnt > 0u ? cnt : 1u;
}

__device__ __forceinline__ void xcd_barrier(const XcdBarrier& b) {
    asm volatile("s_waitcnt vmcnt(0)" ::: "memory");
    __syncthreads();
    if (threadIdx.x == 0) {
        unsigned* bar = b.bar;
        __builtin_amdgcn_s_waitcnt(0);
        unsigned nloc = b.st[0], nx = b.st[1];
        if (nloc == 0u) { xcd_barrier_complete(bar, b.x, nloc, nx); b.st[0] = nloc; b.st[1] = nx; }
        const unsigned old = xb_add(&bar[XB_XSUB(b.x)], 1u);
        const unsigned gen = old / nloc;
        if (old + 1u == (gen + 1u) * nloc) {
            __builtin_amdgcn_fence(__ATOMIC_RELEASE, "agent");
            asm volatile("s_waitcnt vmcnt(0)" ::: "memory");
            const unsigned og = xb_add(&bar[XB_TOP], 1u);
            const unsigned tg = og / nx;
            if (og + 1u == (tg + 1u) * nx) xb_add(&bar[XB_TOPGEN], 1u);
            else XB_SPIN(xb_ld(&bar[XB_TOPGEN]) == tg, bar);
            __builtin_amdgcn_fence(__ATOMIC_ACQUIRE, "agent");
            xb_add(&bar[XB_XGEN(b.x)], 1u);
            asm volatile("s_waitcnt vmcnt(0)" ::: "memory");
        } else {
            XB_SPIN(xb_ld(&bar[XB_XGEN(b.x)]) == gen, bar);
            __builtin_amdgcn_fence(__ATOMIC_ACQUIRE, "agent");
            asm volatile("s_waitcnt vmcnt(0)" ::: "memory");
        }
    }
    __syncthreads();
}

#ifndef MK_MULTI
#define MK_MULTI 0
#endif
constexpr int PH_PER_LAYER = 12, N_PHASES = 2 + NL * PH_PER_LAYER + 1;

__device__ __forceinline__ int static_unit_pm(int M, int N, int G, int c, int i) {
    const int nM = M / 256, nN = N / 256, nwg = nM * nN; const long L = (long)i * G + c; if (L >= nwg) return -1;
    int wgid = (int)L; { const int q = nwg / 8, r = nwg % 8, xcd = wgid % 8, off = wgid / 8; wgid = (xcd < r ? xcd * (q + 1) : r * (q + 1) + (xcd - r) * q) + off; }
    const int nig = pg8::WGM * nN, gid = wgid / nig, fm = gid * pg8::WGM, gsz = (nM - fm) < pg8::WGM ? (nM - fm) : pg8::WGM;
    return fm + ((wgid % nig) % gsz);
}
__device__ __forceinline__ int static_unit_pmpn(int M, int N, int G, int c, int i) {
    const int nM = M / 256, nN = N / 256, nwg = nM * nN; const long L = (long)i * G + c; if (L >= nwg) return -1;
    int wgid = (int)L; { const int q = nwg / 8, r = nwg % 8, xcd = wgid % 8, off = wgid / 8; wgid = (xcd < r ? xcd * (q + 1) : r * (q + 1) + (xcd - r) * q) + off; }
    const int nig = pg8::WGM * nN, gid = wgid / nig, fm = gid * pg8::WGM, gsz = (nM - fm) < pg8::WGM ? (nM - fm) : pg8::WGM;
    return ((fm + ((wgid % nig) % gsz)) << 4) | ((wgid % nig) / gsz);
}
__device__ __forceinline__ unsigned* seam_ctr(unsigned char* ws, int l, int s, int id) { return (unsigned*)(ws + WS_CTL) + 16384 + ((l * 3 + s) * 80 + id) * 16; }
__device__ __forceinline__ void seam_arrive2(unsigned* c1, unsigned* c2) {
    asm volatile("s_waitcnt vmcnt(0)" ::: "memory"); __syncthreads();
    if (threadIdx.x == 0) { __builtin_amdgcn_fence(__ATOMIC_RELEASE, "agent"); asm volatile("s_waitcnt vmcnt(0)" ::: "memory");
        (void)__hip_atomic_fetch_add(c1, 1u, __ATOMIC_RELAXED, __HIP_MEMORY_SCOPE_AGENT); (void)__hip_atomic_fetch_add(c2, 1u, __ATOMIC_RELAXED, __HIP_MEMORY_SCOPE_AGENT); }
}
__device__ __forceinline__ void seam_wait(unsigned* c, unsigned n) {
    if (threadIdx.x == 0) { unsigned sp = 0; while (__hip_atomic_load(c, __ATOMIC_RELAXED, __HIP_MEMORY_SCOPE_AGENT) < n) { __builtin_amdgcn_s_sleep(1); if (++sp > (1u << 22)) break; }
        __builtin_amdgcn_fence(__ATOMIC_ACQUIRE, "agent"); asm volatile("s_waitcnt vmcnt(0)" ::: "memory"); }
    __syncthreads();
}
__device__ __forceinline__ void al_fixup_panel(KArgs ap, int l, int pm, int tid) {
    unsigned char* ws = ap->ws; const bf16* PJ = (const bf16*)(ws + WS_PROJ); const bf16* R63 = (const bf16*)(ws + WS_R63); bf16* AL = (bf16*)(ws + WS_AL); const float* mua = ap->in[I_MU] + (size_t)l * 3328 + C_WL;
    if (pm >= MP / 256 || tid >= 128) return;
    const int m = pm * 256 + (tid >> 5) * 64, j0 = (tid & 31) * 8; const f8 cur = ld8b(PJ + (size_t)m * INC + C_WL + j0);
    f8 prev = zero8(); if (m & (SEQ - 1)) prev = ld8b(R63 + (size_t)((m >> 6) - 1) * 3328 + C_WL + j0);
    f8 xs = mix8(cur, prev, ld8f(mua + j0));
    if (j0 < 64) { xs = sigm8(scl8(xs, 2.0f)); xs.a = xs.a * 2.0f - 1.0f; xs.b = xs.b * 2.0f - 1.0f; }
    else if (j0 >= 128) xs = sigm8(xs);
    *(u32x4*)(AL + (size_t)m * 256 + j0) = pack8(xs);
}
__device__ __forceinline__ void subset_barrier(unsigned* ctr, unsigned n) {
    asm volatile("s_waitcnt vmcnt(0)" ::: "memory"); __syncthreads();
    if (threadIdx.x == 0) {
        __builtin_amdgcn_fence(__ATOMIC_RELEASE, "agent"); asm volatile("s_waitcnt vmcnt(0)" ::: "memory");
        (void)__hip_atomic_fetch_add(ctr, 1u, __ATOMIC_RELAXED, __HIP_MEMORY_SCOPE_AGENT);
        unsigned sp = 0; while (__hip_atomic_load(ctr, __ATOMIC_RELAXED, __HIP_MEMORY_SCOPE_AGENT) < n) { __builtin_amdgcn_s_sleep(2); if (++sp > (1u << 22)) break; }
        __builtin_amdgcn_fence(__ATOMIC_ACQUIRE, "agent"); asm volatile("s_waitcnt vmcnt(0)" ::: "memory");
    }
    __syncthreads();
}
template <class Epi> __device__ __forceinline__ void run_gemm(LAS unsigned char* lds, const bf16* A, const bf16* Bt, int M, int N, int K, int G, int bid, const Epi& E) {
    pg8::Gemm g{A, Bt, M, N, K}; pg8::StaticOrder S; S.init(M, N, G, bid);
    pg8::gemm_phase<Epi, pg8::StaticOrder, true, true>((PG8_LAS unsigned char*)lds, g, S, E);
}

__global__ void __launch_bounds__(NTHR, 2) mega_fwd(Args a_unused) {
    extern __shared__ __attribute__((aligned(16))) unsigned char lds_raw[];
    LAS unsigned char* lds = (LAS unsigned char*)lds_raw;
    const int bid = blockIdx.x, G = gridDim.x;
#define TIDS const int tid = opqv((int)threadIdx.x), lane = tid & 63, wave = __builtin_amdgcn_readfirstlane(tid >> 6); (void)lane; (void)wave;
    int lo, hi; XcdBarrier bar;
    { KArgs ap0 = fresh_args(); lo = ap0->ph_lo; hi = ap0->ph_hi;
      volatile LAS unsigned* misc = (volatile LAS unsigned*)(lds + MISC_OFF);
      if (threadIdx.x < 4) misc[threadIdx.x] = 0u;
      __syncthreads();
      bar = xcd_barrier_post((unsigned*)(ap0->ws + WS_CTL), misc); }
#ifndef EN_MASK
#define EN_MASK 0xffffffffu
#endif
#define EN(x) ((EN_MASK >> (x)) & 1u)
#ifndef REP_MASK
#define REP_MASK 0u
#endif
#define REPS(x) for (int rp_ = 0; rp_ <= (int)((REP_MASK >> (x)) & 1u); ++rp_)
#define IN(k) (lo <= (k) && (k) < hi)
#define SEAM(k) do { if (IN(k) && IN((k) + 1)) { xcd_barrier(bar); } } while (0)
#define WSP(T, off) ((T*)(ws + (off)))
    REPS(0) if (EN(0) && IN(0)) { TIDS phase_prep(fresh_args(), lds, tid, lane, wave, opq(bid), opq(G), 0); }
    SEAM(0);
    REPS(1) if (EN(1) && IN(1)) { KArgs ap = fresh_args(); unsigned char* ws = ap->ws; EpiF32Bias E{WSP(float, WS_MOD), NMOD2, ap->in[I_ADAB]};
        pg8::Gemm g{WSP(const bf16, WS_CALL), WSP(const bf16, WS_ADA), 256, NMOD2, D}; pg8::StaticOrder S; S.init(256, NMOD2, opq(G), opq(bid));
        pg8::gemm_phase<EpiF32Bias, pg8::StaticOrder, true, true>((PG8_LAS unsigned char*)lds, g, S, E);
        constexpr int NADA = NMOD2 / 256;
        if (G > NADA) { if (bid >= NADA) { TIDS phase_prep(fresh_args(), lds, tid, lane, wave, opq(bid) - NADA, opq(G) - NADA, 2); } }
        else { __syncthreads(); TIDS phase_prep(fresh_args(), lds, tid, lane, wave, opq(bid), opq(G), 2); } }
    SEAM(1);
#pragma nounroll
    for (int l = 0; l < NL; ++l) {
        const int P = 2 + l * PH_PER_LAYER;
        if (l == 0) {
        REPS(2) if (EN(2) && IN(P + 0)) { TIDS const int gw_ = opq(bid) * NWAVES + wave, ngw_ = opq(G) * NWAVES; phase_rowpass(fresh_args(), 0, l, lane, gw_, ngw_, gw_, ngw_, MT, true); }
        SEAM(P + 0); }
        REPS(3) if (EN(3) && IN(P + 1)) { KArgs ap = fresh_args(); unsigned char* ws = ap->ws;
            EpiProj E{WSP(bf16, WS_PROJ), WSP(bf16, WS_AL), WSP(bf16, WS_R63), ap->in[I_MU] + (size_t)l * 3328}; run_gemm(lds, WSP(const bf16, WS_H), WSP(const bf16, WS_WIN + l * SZ_WIN), MPAD, INC, D, opq(G), opq(bid), E); }
        SEAM(P + 1);
        REPS(5) if (EN(5) && IN(P + 3)) {
            { TIDS KArgs apf = fresh_args(); const int Gq = opq(G), cq_ = opq(bid); for (int i = 0; ; ++i) { const int pm_ = static_unit_pm(MPAD, 3072, Gq, cq_, i); if (pm_ < 0) break; al_fixup_panel(apf, l, pm_, tid); }
              asm volatile("s_waitcnt vmcnt(0)" ::: "memory"); __syncthreads(); }
            { KArgs ap = fresh_args(); unsigned char* ws = ap->ws; pg8::EpiBf16<0> E{WSP(bf16, WS_LO), 3072, WSP(const float, WS_LBIAS) + l * 3072, 0, 0, 1.f};
              run_gemm(lds, WSP(const bf16, WS_AL), WSP(const bf16, WS_LORA + l * SZ_LORA), MPAD, 3072, 256, opq(G), opq(bid), E); }
 }
        SEAM(P + 3);
        REPS(6) if (EN(6) && IN(P + 4)) {
            if (G > NB * NH && bid >= NB * NH) {
                { TIDS phase_prepC(fresh_args(), l, (opq(bid) - NB * NH) * NTHR + tid, (opq(G) - NB * NH) * NTHR); }
                KArgs ap = fresh_args(); unsigned char* ws = ap->ws;
                subset_barrier((unsigned*)(ap->ws + WS_CTL) + 8192 + 64 * l + 32, (unsigned)(G - NB * NH));
                pg8::EpiBf16<0> E{WSP(bf16, WS_PM), 512, nullptr, 0, 0, 1.f};
                run_gemm(lds, WSP(const bf16, WS_PD), WSP(const bf16, WS_PW + l * SZ_PW), MPAD, 512, 512, opq(G) - NB * NH, opq(bid) - NB * NH, E);
                __syncthreads();
                subset_barrier((unsigned*)(ap->ws + WS_CTL) + 8192 + 64 * l, (unsigned)(G - NB * NH));
                { KArgs ap2 = fresh_args(); unsigned char* ws = ap2->ws; EpiGate E2{WSP(const bf16, WS_PROJ) + C_GP, INC, WSP(bf16, WS_MG), D, 0};
                  run_gemm(lds, WSP(const bf16, WS_PM), WSP(const bf16, WS_WBP + l * SZ_WBP), MP, D, 512, opq(G) - NB * NH, opq(bid) - NB * NH, E2); }
                __syncthreads();
                { TIDS phase_prep(fresh_args(), lds, tid, lane, wave, opq(bid) - NB * NH, opq(G) - NB * NH, l == 0 ? 1 : 3); __syncthreads(); } }
            else if (G <= NB * NH) {
                KArgs ap = fresh_args(); unsigned char* ws = ap->ws; pg8::EpiBf16<0> E{WSP(bf16, WS_PM), 512, nullptr, 0, 0, 1.f};
                run_gemm(lds, WSP(const bf16, WS_PD), WSP(const bf16, WS_PW + l * SZ_PW), MPAD, 512, 512, opq(G), opq(bid), E);
                __syncthreads(); }
            { TIDS phase_scan(fresh_args(), l, lds, tid, lane, wave, opq(bid), opq(G)); } }
        SEAM(P + 4);
        REPS(8) if (EN(8) && IN(P + 6)) {

            { KArgs ap = fresh_args(); unsigned char* ws = ap->ws; EpiGate E{WSP(const bf16, WS_PROJ) + C_GR, INC, WSP(bf16, WS_MG), D, 1};
              run_gemm(lds, WSP(const bf16, WS_Y), WSP(const bf16, WS_WBR + l * SZ_WBR), MP, D, D, opq(G), opq(bid), E); }
            { TIDS KArgs ap = fresh_args(); unsigned char* ws = ap->ws; skinny_phase<0>(ap, l, 0, WSP(const bf16, WS_PM), WSP(const bf16, WS_WBP + l * SZ_WBP), 512, WSP(const bf16, WS_Y), WSP(const bf16, WS_WBR + l * SZ_WBR), D, lds, tid, lane, wave, opq(bid), opq(G)); }
            { KArgs ap = fresh_args(); unsigned char* ws = ap->ws; const int pp = static_unit_pmpn(MP, D, opq(G), opq(bid), 0);
              seam_arrive2(seam_ctr(ws, l, 2, pp >> 4), seam_ctr(ws, l, 2, 64 + (bid & 3))); seam_wait(seam_ctr(ws, l, 2, pp >> 4), 4u); } }
        REPS(9) if (EN(9) && IN(P + 7)) { KArgs ap = fresh_args(); unsigned char* ws = ap->ws; EpiRes E{WSP(bf16, WS_XB), WSP(const float, WS_MOD) + l * NMOD + 2 * D};
            run_gemm(lds, WSP(const bf16, WS_MG), WSP(const bf16, WS_WOUT + l * SZ_WOUT), MP, D, D, opq(G), opq(bid), E);
            seam_wait(seam_ctr(ws, l, 2, 64 + (bid & 3)), 64u);
            { TIDS skinny_phase<1>(ap, l, 2, WSP(const bf16, WS_MG), WSP(const bf16, WS_WOUT + l * SZ_WOUT), D, nullptr, nullptr, 0, lds, tid, lane, wave, opq(bid), opq(G)); }
            { TIDS const int pp = static_unit_pmpn(MP, D, opq(G), opq(bid), 0), pm = pp >> 4, pn = pp & 15, rb = bid & 3;
              seam_arrive2(seam_ctr(ws, l, 0, pm), seam_ctr(ws, l, 0, 64 + rb)); seam_wait(seam_ctr(ws, l, 0, pm), 4u);
              phase_rowpass(ap, 1, l, lane, 0, 1, pm * 256 + pn * 64 + wave, 8, pm * 256 + pn * 64 + 64, false);
              if (bid < 16) { seam_wait(seam_ctr(ws, l, 0, 64 + rb), 64u); const int ms = MP + rb * 32 + (bid >> 2) * 8 + wave; phase_rowpass(ap, 1, l, lane, 0, 1, ms, 8, ms + 1, false); } } }
        SEAM(P + 8);
        REPS(11) if (EN(11) && IN(P + 9)) { KArgs ap = fresh_args(); unsigned char* ws = ap->ws; EpiConv E{WSP(bf16, WS_U), WSP(bf16, WS_ACT), ap->in[I_CW] + (size_t)l * 3 * FF2, ap->in[I_CB] + (size_t)l * FF2};
            run_gemm(lds, WSP(const bf16, WS_H), WSP(const bf16, WS_UP + l * SZ_UP), MPAD, FF2, D, opq(G), opq(bid), E); }
        SEAM(P + 9);
        REPS(12) if (EN(12) && IN(P + 10)) { TIDS phase_conv(fresh_args(), l, opq(bid) * NTHR + tid, opq(G) * NTHR); }
        SEAM(P + 10);
        REPS(13) if (EN(13) && IN(P + 11)) { KArgs ap = fresh_args(); unsigned char* ws = ap->ws; EpiRes E{WSP(bf16, WS_XB), WSP(const float, WS_MOD) + l * NMOD + 5 * D};
            run_gemm(lds, WSP(const bf16, WS_ACT), WSP(const bf16, WS_DOWN + l * SZ_DOWN), MP, D, DFF, opq(G), opq(bid), E);
            { TIDS skinny_phase<1>(ap, l, 5, WSP(const bf16, WS_ACT), WSP(const bf16, WS_DOWN + l * SZ_DOWN), DFF, nullptr, nullptr, 0, lds, tid, lane, wave, opq(bid), opq(G)); }
            { TIDS const int pp = static_unit_pmpn(MP, D, opq(G), opq(bid), 0), pm = pp >> 4, pn = pp & 15, rb = bid & 3, st = (l + 1 < NL) ? 2 : 3;
              phase_rowpass(ap, st, l + 1, lane, opq(bid) * NWAVES + wave, opq(G) * NWAVES, 0, 1, 0, true);
              seam_arrive2(seam_ctr(ws, l, 1, pm), seam_ctr(ws, l, 1, 64 + rb)); seam_wait(seam_ctr(ws, l, 1, pm), 4u);
              phase_rowpass(ap, st, l + 1, lane, 0, 1, pm * 256 + pn * 64 + wave, 8, pm * 256 + pn * 64 + 64, false);
              if (bid < 16) { seam_wait(seam_ctr(ws, l, 1, 64 + rb), 64u); const int ms = MP + rb * 32 + (bid >> 2) * 8 + wave; phase_rowpass(ap, st, l + 1, lane, 0, 1, ms, 8, ms + 1, false); } } }
        if (l + 1 < NL) SEAM(P + 11);
    }
#undef IN
#undef SEAM
}

extern "C" void kernel_launch(void* const* d_in, const int* in_sizes, int n_in, void* d_out, int out_size, void* d_ws, size_t ws_size, hipStream_t stream) {
    static int grid = 0;
    if (grid == 0) {
        if (n_in != N_IN || (size_t)out_size != O_END || ws_size < WS_END) { fprintf(stderr, "kernel_launch: unexpected shapes (n_in %d out %d ws %zu)\n", n_in, out_size, ws_size); grid = -1; return; }
        int dev = 0, cus = 0, per_cu = 0;
        if (hipGetDevice(&dev) != hipSuccess || hipDeviceGetAttribute(&cus, hipDeviceAttributeMultiprocessorCount, dev) != hipSuccess) { grid = -1; return; }
        if (hipFuncSetAttribute((const void*)mega_fwd, hipFuncAttributeMaxDynamicSharedMemorySize, LDS_BYTES) != hipSuccess) { fprintf(stderr, "kernel_launch: hipFuncSetAttribute failed\n"); grid = -1; return; }
        if (hipOccupancyMaxActiveBlocksPerMultiprocessor(&per_cu, (const void*)mega_fwd, NTHR, LDS_BYTES) != hipSuccess || per_cu < 1) { fprintf(stderr, "kernel_launch: occupancy query says %d\n", per_cu); per_cu = 1; }
        (void)hipGetLastError();
        grid = cus * 1;
        if (grid != 256) { fprintf(stderr, "kernel_launch: the counted seams of this schedule need exactly 256 workgroups (one per CU of a 256-CU device), got %d\n", grid); grid = -1; return; }
        if (grid <= NB * NH) { fprintf(stderr, "kernel_launch: this schedule needs more than %d workgroups (CUs), got %d\n", NB * NH, grid); grid = -1; return; }
    }
    if (grid < 0) return;
    if (hipMemsetAsync((char*)d_ws + WS_CTL, 0, CTL_ZERO_BYTES, stream) != hipSuccess) { fprintf(stderr, "kernel_launch: memset failed\n"); return; }
    Args a{};
    for (int i = 0; i < N_IN; ++i) a.in[i] = (const float*)d_in[i];
    a.out = (float*)d_out; a.ws = (unsigned char*)d_ws;
#if MK_MULTI
    for (int p = 0; p < N_PHASES; ++p) { a.ph_lo = p; a.ph_hi = p + 1; hipLaunchKernelGGL(mega_fwd, dim3(grid), dim3(NTHR), LDS_BYTES, stream, a); }
#else
    a.ph_lo = 0; a.ph_hi = N_PHASES;
    void* args[] = {&a};
    hipError_t e = hipLaunchCooperativeKernel((const void*)mega_fwd, dim3(grid), dim3(NTHR), args, LDS_BYTES, stream);
    if (e != hipSuccess) fprintf(stderr, "kernel_launch: cooperative launch failed: %s (grid %d)\n", hipGetErrorString(e), grid);
#endif
}
```
